# Optimizing an MI355X kernel written in HIP

```python
import jax, jax.numpy as jnp
from jax import lax
import numpy as np

D_MODEL = 1024
BATCH = 4
SEQ = 4096
DEPTH = 1

CHUNK = 64
Q_BLOCK = 128
HEAD_DIM = 64
ROPE_THETA = 10000.0
EPS = 1e-6

N_DIFF_HEADS = 4
DIFF_V_DIM = 2 * HEAD_DIM
DIFF_QK = N_DIFF_HEADS * 2 * HEAD_DIM
DIFF_V = N_DIFF_HEADS * DIFF_V_DIM
N_FOX_HEADS = 8
FOX_W = N_FOX_HEADS * HEAD_DIM
MIX_W = DIFF_V + FOX_W
PROJ_WIDTHS = (DIFF_QK, DIFF_QK, DIFF_V, FOX_W, FOX_W, FOX_W, N_FOX_HEADS)
D_IN = sum(PROJ_WIDTHS)

N_GROUPS = 4
EXPERTS_PER_GROUP = 4
N_EXPERTS = N_GROUPS * EXPERTS_PER_GROUP
TOP_K_IN_GROUP = 2
D_EXPERT = D_MODEL // 2

kernel_name = "hybrid_diffattn_fox_hiermoe_chunk_causal"


def _rmsnorm(x, g):
    xf = x.astype(jnp.float32)
    y = xf * lax.rsqrt(jnp.mean(xf * xf, axis=-1, keepdims=True) + EPS)
    return (y * g.astype(jnp.float32)).astype(x.dtype)


def _rotate_half(x):
    x1, x2 = jnp.split(x, 2, axis=-1)
    return jnp.concatenate([-x2, x1], axis=-1)


def _rope(x, cos, sin):
    return (x * cos + _rotate_half(x) * sin).astype(x.dtype)


def _diff_attention(q1, q2, k1, k2, v, lam):
    S = q1.shape[2]
    scale = HEAD_DIM ** -0.5
    outs = []
    for blk in range(S // Q_BLOCK):
        q0, q1_end = blk * Q_BLOCK, (blk + 1) * Q_BLOCK
        t = np.arange(q0, q1_end)
        s = np.arange(q1_end)
        mask = (s[None, :] // CHUNK) <= (t[:, None] // CHUNK)

        def probs(q, k):
            logits = jnp.einsum('bhqd,bhkd->bhqk', q[:, :, q0:q1_end], k[:, :, :q1_end]).astype(jnp.float32) * scale
            return jax.nn.softmax(jnp.where(mask, logits, -jnp.inf), axis=-1)

        w = probs(q1, k1) - lam * probs(q2, k2)
        outs.append(jnp.einsum('bhqk,bhkd->bhqd', w.astype(v.dtype), v[:, :, :q1_end]))
    return jnp.concatenate(outs, axis=2)


def _forgetting_attention(q, k, v, cum_logf):
    S = q.shape[2]
    scale = HEAD_DIM ** -0.5
    outs = []
    for blk in range(S // Q_BLOCK):
        q0, q_end = blk * Q_BLOCK, (blk + 1) * Q_BLOCK
        t = np.arange(q0, q_end)
        s = np.arange(q_end)
        mask = s[None, :] <= t[:, None]
        logits = jnp.einsum('bhqd,bhkd->bhqk', q[:, :, q0:q_end], k[:, :, :q_end]).astype(jnp.float32) * scale
        logits = logits + cum_logf[:, :, q0:q_end, None] - cum_logf[:, :, None, :q_end]
        p = jax.nn.softmax(jnp.where(mask, logits, -jnp.inf), axis=-1)
        outs.append(jnp.einsum('bhqk,bhkd->bhqd', p.astype(v.dtype), v[:, :, :q_end]))
    return jnp.concatenate(outs, axis=2)


def _hier_moe(h, wg_r, bg_r, we_r, be_r, w_gate, w_up, w_down):
    g_logits = (h @ wg_r).astype(jnp.float32) + bg_r.astype(jnp.float32)
    g_probs = jax.nn.softmax(g_logits, axis=-1)
    g_w, g_idx = lax.top_k(g_probs, 1)
    e_logits = (h @ we_r).astype(jnp.float32) + be_r.astype(jnp.float32)
    e_logits = e_logits.reshape(-1, N_GROUPS, EXPERTS_PER_GROUP)
    sel = jnp.take_along_axis(e_logits, g_idx[:, :, None], axis=1)[:, 0]
    top_v, top_i = lax.top_k(sel, TOP_K_IN_GROUP)
    weights = g_w * jax.nn.softmax(top_v, axis=-1)
    expert_ids = g_idx * EXPERTS_PER_GROUP + top_i
    combine = jnp.sum(jax.nn.one_hot(expert_ids, N_EXPERTS, dtype=jnp.float32) * weights[:, :, None], axis=1)
    y = jnp.zeros_like(h)
    for e in range(N_EXPERTS):
        a = jax.nn.silu(h @ w_gate[e]) * (h @ w_up[e])
        y = y + combine[:, e:e + 1].astype(h.dtype) * (a @ w_down[e])
    return y


def setup_inputs(seed: int = 0) -> dict:
    key = jax.random.key(seed)
    ks = jax.random.split(key, 20)
    f32 = jnp.float32
    nrm = lambda k, shape, s: jax.random.normal(k, shape, f32) * s
    gain = lambda k, shape: 1.0 + 0.02 * jax.random.normal(k, shape, f32)
    return {
        "x": jax.random.normal(ks[0], (BATCH, SEQ, D_MODEL), f32),
        "norm_attn_g": gain(ks[1], (DEPTH, D_MODEL)),
        "w_in": nrm(ks[2], (DEPTH, D_MODEL, D_IN), D_MODEL ** -0.5),
        "b_forget": jax.random.uniform(ks[3], (DEPTH, N_FOX_HEADS), f32, 1.0, 4.0),
        "lambda_q1": nrm(ks[4], (DEPTH, HEAD_DIM), 0.1),
        "lambda_k1": nrm(ks[5], (DEPTH, HEAD_DIM), 0.1),
        "lambda_q2": nrm(ks[6], (DEPTH, HEAD_DIM), 0.1),
        "lambda_k2": nrm(ks[7], (DEPTH, HEAD_DIM), 0.1),
        "diff_norm_g": gain(ks[8], (DEPTH, DIFF_V_DIM)),
        "w_out": nrm(ks[9], (DEPTH, MIX_W, D_MODEL), MIX_W ** -0.5),
        "norm_ffn_g": gain(ks[10], (DEPTH, D_MODEL)),
        "router_group_w": nrm(ks[11], (DEPTH, D_MODEL, N_GROUPS), D_MODEL ** -0.5),
        "router_group_b": nrm(ks[12], (DEPTH, N_GROUPS), 0.01),
        "router_expert_w": nrm(ks[13], (DEPTH, D_MODEL, N_EXPERTS), D_MODEL ** -0.5),
        "router_expert_b": nrm(ks[14], (DEPTH, N_EXPERTS), 0.01),
        "w_gate": nrm(ks[15], (DEPTH, N_EXPERTS, D_MODEL, D_EXPERT), D_MODEL ** -0.5),
        "w_up": nrm(ks[16], (DEPTH, N_EXPERTS, D_MODEL, D_EXPERT), D_MODEL ** -0.5),
        "w_down": nrm(ks[17], (DEPTH, N_EXPERTS, D_EXPERT, D_MODEL), D_EXPERT ** -0.5),
        "norm_final_g": gain(ks[18], (D_MODEL,)),
    }


def reference(x, norm_attn_g, w_in, b_forget, lambda_q1, lambda_k1, lambda_q2, lambda_k2,
              diff_norm_g, w_out, norm_ffn_g, router_group_w, router_group_b,
              router_expert_w, router_expert_b, w_gate, w_up, w_down, norm_final_g):
    B, S, D = x.shape
    pos = jnp.arange(S, dtype=jnp.float32)
    inv_freq = 1.0 / (ROPE_THETA ** (jnp.arange(0, HEAD_DIM, 2, dtype=jnp.float32) / HEAD_DIM))
    ang = pos[:, None] * inv_freq[None, :]
    ang = jnp.concatenate([ang, ang], axis=-1)
    cos, sin = jnp.cos(ang), jnp.sin(ang)
    splits = [int(i) for i in np.cumsum(PROJ_WIDTHS)[:-1]]

    for l in range(DEPTH):
        lam_init = 0.8 - 0.6 * float(np.exp(-0.3 * l))
        h = _rmsnorm(x, norm_attn_g[l])
        proj = h @ w_in[l]
        q_d, k_d, v_d, q_f, k_f, v_f, f_logit = jnp.split(proj, splits, axis=-1)

        q_d = _rope(q_d.reshape(B, S, N_DIFF_HEADS, 2, HEAD_DIM).transpose(3, 0, 2, 1, 4), cos, sin)
        k_d = _rope(k_d.reshape(B, S, N_DIFF_HEADS, 2, HEAD_DIM).transpose(3, 0, 2, 1, 4), cos, sin)
        v_d = v_d.reshape(B, S, N_DIFF_HEADS, DIFF_V_DIM).transpose(0, 2, 1, 3)
        lam = (jnp.exp(jnp.sum(lambda_q1[l].astype(jnp.float32) * lambda_k1[l].astype(jnp.float32)))
               - jnp.exp(jnp.sum(lambda_q2[l].astype(jnp.float32) * lambda_k2[l].astype(jnp.float32)))
               + lam_init)
        o_d = _diff_attention(q_d[0], q_d[1], k_d[0], k_d[1], v_d, lam)
        o_d = _rmsnorm(o_d, diff_norm_g[l]) * (1.0 - lam_init)
        o_d = o_d.transpose(0, 2, 1, 3).reshape(B, S, DIFF_V).astype(x.dtype)

        to_heads = lambda t: t.reshape(B, S, N_FOX_HEADS, HEAD_DIM).transpose(0, 2, 1, 3)
        log_f = jax.nn.log_sigmoid(f_logit.astype(jnp.float32) + b_forget[l].astype(jnp.float32))
        cum_logf = jnp.cumsum(log_f.transpose(0, 2, 1), axis=-1)
        o_f = _forgetting_attention(to_heads(q_f), to_heads(k_f), to_heads(v_f), cum_logf)
        o_f = o_f.transpose(0, 2, 1, 3).reshape(B, S, FOX_W).astype(x.dtype)

        x = x + jnp.concatenate([o_d, o_f], axis=-1) @ w_out[l]

        hm = _rmsnorm(x, norm_ffn_g[l]).reshape(B * S, D)
        y = _hier_moe(hm, router_group_w[l], router_group_b[l], router_expert_w[l], router_expert_b[l],
                      w_gate[l], w_up[l], w_down[l])
        x = x + y.reshape(B, S, D)

    return _rmsnorm(x, norm_final_g)
```

```cpp
#include <hip/hip_runtime.h>
#include <hip/hip_bf16.h>
#include <cstdio>
#include <cstdint>
#include <cmath>
namespace pg8 {
#define PG8_LAS __attribute__((address_space(3)))
typedef unsigned short bf16_t;
typedef short bf16x8 __attribute__((ext_vector_type(8)));
typedef float f32x4 __attribute__((ext_vector_type(4)));
typedef unsigned u32x4 __attribute__((ext_vector_type(4)));
constexpr int BM = 256, BK = 64, HALF = 128, HTB = HALF * BK * 2  , STAGE_BYTES = 8 * HTB, NXCD = 8, WGM = 8;

__host__ __device__ __forceinline__ int lds_byte(int r, int c) { const int st = (r >> 4) * 2 + (c >> 5), rr = r & 15, cc = c & 31, ob = rr * 64 + cc * 2; return st * 1024 + (ob ^ (((ob >> 9) & 1) << 5)); }
__host__ __device__ __forceinline__ void stage_rc(int b, int& R, int& C) { const int st = b / 1024, sb = b % 1024, swz = sb ^ (((sb >> 9) & 1) << 5); R = (st >> 1) * 16 + swz / 64; C = (st & 1) * 32 + (swz % 64) / 2; }
__host__ __device__ __forceinline__ int perm32(int rho) { const int n = rho >> 4, i = rho & 15; return 8 * (i >> 2) + 4 * n + (i & 3); }

struct Unit { int pm, pn, bn, nv, e, mt; };
struct Gemm { const bf16_t* A; const bf16_t* Bt; int K; };

struct StaticOrder {
    int nM, nN, nwg, G, c;
    __device__ void init(int M, int N, int G_, int c_) { nM = M / BM; nN = N / BM; nwg = nM * nN; G = G_; c = c_; }
    __device__ __forceinline__ bool next(int i, Unit& u) const {
        const long L = (long)i * G + c; if (L >= nwg) return false;
        int wgid = (int)L; { const int q = nwg / NXCD, r = nwg % NXCD, xcd = wgid % NXCD, off = wgid / NXCD; wgid = (xcd < r ? xcd * (q + 1) : r * (q + 1) + (xcd - r) * q) + off; }
        const int nig = WGM * nN, gid = wgid / nig, fm = gid * WGM, gsz = (nM - fm) < WGM ? (nM - fm) : WGM;
        u.pm = fm + ((wgid % nig) % gsz); u.pn = (wgid % nig) / gsz; u.bn = u.pn; u.nv = BM; u.e = 0; u.mt = 0; return true;
    }
    __device__ __forceinline__ void aoff(const Unit& u, const int (&R)[2], const int (&C)[2], int K, unsigned (&vo)[2][2]) const {
#pragma unroll
        for (int h = 0; h < 2; ++h)
#pragma unroll
            for (int i = 0; i < 2; ++i) vo[h][i] = (unsigned)((u.pm * BM + h * HALF + R[i]) * K + C[i]) * 2u;
    }
};

template <bool GATHER> struct ExpertOrder {
    int cnt[16]; int T, G, c; const int* list;
    __device__ __forceinline__ void init(const unsigned* cw, int G_, int c_, const int* list_) {
        T = 0;
#pragma unroll
        for (int e = 0; e < 16; ++e) { cnt[e] = (int)__builtin_amdgcn_readfirstlane(__hip_atomic_load(cw + 64 * e, __ATOMIC_RELAXED, __HIP_MEMORY_SCOPE_AGENT)); if (cnt[e] > 16384) cnt[e] = 16384; T += (cnt[e] + 255) >> 8; }
        G = G_; c = c_; list = list_;
    }
    __device__ __forceinline__ bool next(int i, Unit& u) const {
        const int L = i * G + c; if (L >= 4 * T) return false;
        const int rt = L >> 2; int acc = 0; u.e = 0; u.mt = 0; u.nv = 0;
#pragma unroll
        for (int e = 0; e < 16; ++e) { const int te = (cnt[e] + 255) >> 8; if (rt >= acc && rt < acc + te) { u.e = e; u.mt = rt - acc; const int left = cnt[e] - u.mt * 256; u.nv = left < 256 ? left : 256; } acc += te; }
        u.pm = rt; u.pn = L & 3; u.bn = u.e * 4 + u.pn; return true;
    }
    __device__ __forceinline__ void aoff(const Unit& u, const int (&R)[2], const int (&C)[2], int K, unsigned (&vo)[2][2]) const {
#pragma unroll
        for (int h = 0; h < 2; ++h)
#pragma unroll
            for (int i = 0; i < 2; ++i) {
                int row;
                if constexpr (GATHER) { const int rt = h * HALF + R[i]; row = 0; if (rt < u.nv) row = list[u.e * 16384 + u.mt * 256 + rt]; row &= 16383; }
                else row = u.pm * BM + h * HALF + R[i];
                vo[h][i] = (unsigned)(row * K + C[i]) * 2u;
            }
    }
};

__device__ __forceinline__ unsigned cvt_pk_bf16(float lo, float hi) { unsigned r; asm volatile("v_cvt_pk_bf16_f32 %0, %1, %2" : "=v"(r) : "v"(lo), "v"(hi)); return r; }

template <class Epi, class Sched, bool ALIGN_EPI>
__device__ __forceinline__ void gemm_phase(PG8_LAS unsigned char* lds, const Gemm g, const Sched& S, const Epi& E) {
    int tid_ = threadIdx.x; asm volatile("" : "+v"(tid_));
    const int tid = tid_, wid = __builtin_amdgcn_readfirstlane(tid >> 6), lane = tid & 63, wr = wid >> 2, wc = wid & 3, fr = lane & 15, fq = lane >> 4;
    const int K = g.K, nt = K / BK;
    int Rr[2], Cc[2]; unsigned voffB[2];
#pragma unroll
    for (int i = 0; i < 2; ++i) { int R, C; stage_rc(tid * 16 + i * 8192, R, C); Rr[i] = R; Cc[i] = C; const int Rb = (R & ~31) + perm32(R & 31); voffB[i] = (unsigned)(Rb * K + C) * 2u; }
    const unsigned kstep = (unsigned)(BK * 2);
    const size_t hstep = (size_t)HALF * K * 2;
    const size_t tstep = 2 * hstep;
    const unsigned ldsw = (unsigned)wid * 1024u;
    const int aoff = lds_byte(wr * 64 + fr, fq * 8), boff = lds_byte(wc * 32 + fr, fq * 8);
    const char* const Abase = (const char*)g.A;
#define PG8_SA(b, h) (((b) * 2 + (h)) * HTB)
#define PG8_SB(b, h) ((4 + (b) * 2 + (h)) * HTB)
#define PG8_STAGE(bufoff, gbase, voff) do { _Pragma("unroll") for (int _i = 0; _i < 2; ++_i) \
        __builtin_amdgcn_global_load_lds((const unsigned*)((const char*)(gbase) + (voff)[_i]), (PG8_LAS unsigned*)(lds + (bufoff) + ldsw + _i * 8192), 16, 0, 0); } while (0)
#define PG8_LDA(dst, b, h) do { _Pragma("unroll") for (int m = 0; m < 4; ++m) _Pragma("unroll") for (int k = 0; k < 2; ++k) dst[m][k] = *(const PG8_LAS bf16x8*)(lds + PG8_SA(b, h) + aoff + m * 2048 + k * 1024); } while (0)
#define PG8_LDB(dst, b, h) do { _Pragma("unroll") for (int n = 0; n < 2; ++n) _Pragma("unroll") for (int k = 0; k < 2; ++k) dst[n][k] = *(const PG8_LAS bf16x8*)(lds + PG8_SB(b, h) + boff + n * 2048 + k * 1024); } while (0)
#define PG8_MMA(ai, bj, At, Bt) do { __builtin_amdgcn_s_setprio(1); _Pragma("unroll") for (int m = 0; m < 4; ++m) _Pragma("unroll") for (int n = 0; n < 2; ++n) _Pragma("unroll") for (int k = 0; k < 2; ++k) \
        acc[ai][bj][m][n] = __builtin_amdgcn_mfma_f32_16x16x32_bf16(Bt[n][k], At[m][k], acc[ai][bj][m][n], 0, 0, 0); __builtin_amdgcn_s_setprio(0); } while (0)
#define PG8_WAIT_V(n) asm volatile("s_waitcnt vmcnt(" #n ")" ::: "memory")
#define PG8_WAIT_L(n) asm volatile("s_waitcnt lgkmcnt(" #n ")" ::: "memory")
#define PG8_BAR __builtin_amdgcn_s_barrier()
#define PG8_SCHED __builtin_amdgcn_sched_barrier(0)
    Unit cur, nxt; int ui = 0;
    if (!S.next(0, cur)) return;
    f32x4 acc[2][2][4][2];
#pragma unroll
    for (int a = 0; a < 2; ++a)
#pragma unroll
        for (int b = 0; b < 2; ++b)
#pragma unroll
            for (int m = 0; m < 4; ++m)
#pragma unroll
                for (int n = 0; n < 2; ++n) acc[a][b][m][n] = (f32x4){0.f, 0.f, 0.f, 0.f};
    bf16x8 At[4][2], B0[2][2], B1[2][2];
    unsigned vAc[2][2], vAn[2][2];
    S.aoff(cur, Rr, Cc, K, vAc);
    const char* cB = (const char*)g.Bt + (size_t)cur.bn * tstep;
    PG8_STAGE(PG8_SB(0, 0), cB, voffB); PG8_STAGE(PG8_SB(0, 1), cB + hstep, voffB); PG8_STAGE(PG8_SA(0, 0), Abase, vAc[0]); PG8_STAGE(PG8_SA(0, 1), Abase, vAc[1]);
    if (wr == 1) PG8_BAR;
    PG8_WAIT_V(2); PG8_BAR;
    PG8_STAGE(PG8_SB(1, 0), cB + kstep, voffB); PG8_STAGE(PG8_SA(1, 0), Abase + kstep, vAc[0]); PG8_STAGE(PG8_SB(1, 1), cB + hstep + kstep, voffB);
    PG8_WAIT_V(6); PG8_BAR;
    for (;;) {
        const bool has_next = S.next(ui + 1, nxt);
        if (has_next) S.aoff(nxt, Rr, Cc, K, vAn);
        else {
#pragma unroll
            for (int h = 0; h < 2; ++h)
#pragma unroll
                for (int i = 0; i < 2; ++i) vAn[h][i] = vAc[h][i];
        }
        const char* nB = has_next ? (const char*)g.Bt + (size_t)nxt.bn * tstep : cB;
        for (int t = 0; t < nt; t += 2) {
            const bool last = (t == nt - 2);
            const char* a1 = Abase + (size_t)(t + 1) * kstep;
            const char* a2 = last ? Abase : Abase + (size_t)(t + 2) * kstep; const char* b2 = last ? nB : cB + (size_t)(t + 2) * kstep;
            const char* a3 = a2 + kstep; const char* b3 = b2 + kstep;
            unsigned v2[2][2];
#pragma unroll
            for (int h = 0; h < 2; ++h)
#pragma unroll
                for (int i = 0; i < 2; ++i) v2[h][i] = last ? vAn[h][i] : vAc[h][i];
            PG8_LDB(B0, 0, 0); PG8_LDB(B1, 0, 1); PG8_SCHED; PG8_LDA(At, 0, 0); PG8_STAGE(PG8_SA(1, 1), a1, vAc[1]);
            PG8_WAIT_V(8); PG8_WAIT_L(0); PG8_BAR; PG8_MMA(0, 0, At, B0); PG8_MMA(0, 1, At, B1); PG8_BAR; PG8_SCHED;
            PG8_LDA(At, 0, 1); PG8_STAGE(PG8_SB(0, 0), b2, voffB); PG8_STAGE(PG8_SB(0, 1), b2 + hstep, voffB); PG8_STAGE(PG8_SA(0, 0), a2, v2[0]);
            PG8_WAIT_V(8); PG8_WAIT_L(0); PG8_BAR; PG8_MMA(1, 0, At, B0); PG8_MMA(1, 1, At, B1); PG8_BAR; PG8_SCHED;
            PG8_LDB(B0, 1, 0); PG8_LDB(B1, 1, 1); PG8_SCHED; PG8_LDA(At, 1, 0); PG8_STAGE(PG8_SA(0, 1), a2, v2[1]);
            PG8_WAIT_V(8); PG8_WAIT_L(0); PG8_BAR; PG8_MMA(0, 0, At, B0); PG8_MMA(0, 1, At, B1); PG8_BAR; PG8_SCHED;
            PG8_LDA(At, 1, 1); PG8_STAGE(PG8_SB(1, 0), b3, voffB); PG8_STAGE(PG8_SB(1, 1), b3 + hstep, voffB); PG8_STAGE(PG8_SA(1, 0), a3, v2[0]);
            PG8_WAIT_V(8); PG8_WAIT_L(0); PG8_BAR; PG8_MMA(1, 0, At, B0); PG8_MMA(1, 1, At, B1); PG8_BAR; PG8_SCHED;
        }
        if constexpr (ALIGN_EPI) { if (wr == 0) PG8_BAR; }
        E(acc, cur, wr, wc, fr, fq);
        if (!has_next) break;
#pragma unroll
        for (int a = 0; a < 2; ++a)
#pragma unroll
            for (int b = 0; b < 2; ++b)
#pragma unroll
                for (int m = 0; m < 4; ++m)
#pragma unroll
                    for (int n = 0; n < 2; ++n) acc[a][b][m][n] = (f32x4){0.f, 0.f, 0.f, 0.f};
        cur = nxt; cB = nB; ++ui;
#pragma unroll
        for (int h = 0; h < 2; ++h)
#pragma unroll
            for (int i = 0; i < 2; ++i) vAc[h][i] = vAn[h][i];
        if constexpr (ALIGN_EPI) { if (wr == 1) PG8_BAR; }
    }
    PG8_WAIT_V(0);
    if constexpr (!ALIGN_EPI) { if (wr == 0) PG8_BAR; }
    PG8_BAR;
#undef PG8_SA
#undef PG8_SB
#undef PG8_STAGE
#undef PG8_LDA
#undef PG8_LDB
#undef PG8_MMA
#undef PG8_WAIT_V
#undef PG8_WAIT_L
#undef PG8_BAR
#undef PG8_SCHED
}
}
namespace epi {
using pg8::f32x4; using pg8::u32x4; using pg8::Unit; using pg8::bf16_t; using pg8::cvt_pk_bf16;
constexpr int BM = 256, HALF = 128;
__device__ __forceinline__ u32x4 pack8(const f32x4 a, const f32x4 b) { u32x4 w; w.x = cvt_pk_bf16(a[0], a[1]); w.y = cvt_pk_bf16(a[2], a[3]); w.z = cvt_pk_bf16(b[0], b[1]); w.w = cvt_pk_bf16(b[2], b[3]); return w; }

struct EpiProj {
    bf16_t* O; size_t stride; const float* rope; float c2;
    __device__ __forceinline__ void operator()(const f32x4 (&acc)[2][2][4][2], const Unit& u, int wr, int wc, int fr, int fq) const {
        const int kind = u.pn >> 1, hf = u.pn & 1;
        bf16_t* base = O + (size_t)kind * stride;
        const float sc = (kind == 0 || kind == 3) ? c2 : 1.f;
        const int row0 = u.pm * BM + wr * 64 + fr;
        if (kind < 2) {
#pragma unroll
            for (int ai = 0; ai < 2; ++ai)
#pragma unroll
                for (int m = 0; m < 4; ++m) {
                    const int row = row0 + ai * HALF + m * 16; const int pos = row & 4095;
                    const float* rp = rope + pos * 64 + 8 * fq;
                    const f32x4 c0 = *(const f32x4*)(rp), c1 = *(const f32x4*)(rp + 4), s0 = *(const f32x4*)(rp + 32), s1 = *(const f32x4*)(rp + 36);
                    const f32x4 x10 = acc[ai][0][m][0], x11 = acc[ai][0][m][1], x20 = acc[ai][1][m][0], x21 = acc[ai][1][m][1];
                    const f32x4 o10 = (x10 * c0 - x20 * s0) * sc, o11 = (x11 * c1 - x21 * s1) * sc;
                    const f32x4 o20 = (x20 * c0 + x10 * s0) * sc, o21 = (x21 * c1 + x11 * s1) * sc;
                    bf16_t* rowp = base + (size_t)row * 512 + hf * 256 + wc * 64 + 8 * fq;
                    *(u32x4*)(rowp) = pack8(o10, o11);
                    *(u32x4*)(rowp + 32) = pack8(o20, o21);
                }
        } else {
#pragma unroll
            for (int ai = 0; ai < 2; ++ai)
#pragma unroll
                for (int m = 0; m < 4; ++m) {
                    bf16_t* rowp = base + (size_t)(row0 + ai * HALF + m * 16) * 512 + hf * 256 + wc * 32 + 8 * fq;
#pragma unroll
                    for (int bj = 0; bj < 2; ++bj) *(u32x4*)(rowp + bj * HALF) = pack8(acc[ai][bj][m][0] * sc, acc[ai][bj][m][1] * sc);
                }
        }
    }
};

struct EpiRes {
    const float* X; bf16_t* O;
    __device__ __forceinline__ void operator()(const f32x4 (&acc)[2][2][4][2], const Unit& u, int wr, int wc, int fr, int fq) const {
        const int row0 = u.pm * BM + wr * 64 + fr, col0 = u.pn * BM + wc * 32 + 8 * fq;
#pragma unroll
        for (int ai = 0; ai < 2; ++ai)
#pragma unroll
            for (int m = 0; m < 4; ++m) {
                const size_t off = (size_t)(row0 + ai * HALF + m * 16) * 1024 + col0;
#pragma unroll
                for (int bj = 0; bj < 2; ++bj) {
                    const f32x4 xa = *(const f32x4*)(X + off + bj * HALF), xb = *(const f32x4*)(X + off + bj * HALF + 4);
                    *(u32x4*)(O + off + bj * HALF) = pack8(acc[ai][bj][m][0] + xa, acc[ai][bj][m][1] + xb);
                }
                if (m & 1) asm volatile("" ::: "memory");
            }
    }
};

struct EpiSwiglu {
    bf16_t* ACT; const int* list; const float* r2;
    __device__ __forceinline__ void operator()(const f32x4 (&acc)[2][2][4][2], const Unit& u, int wr, int wc, int fr, int fq) const {
        const int rt0 = wr * 64 + fr;
#pragma unroll
        for (int ai = 0; ai < 2; ++ai)
#pragma unroll
            for (int m = 0; m < 4; ++m) {
                const int rt = rt0 + ai * HALF + m * 16;
                int tok = 0; if (rt < u.nv) tok = list[u.e * 16384 + u.mt * 256 + rt]; tok &= 16383;
                const float r = r2[tok];
                f32x4 a[2];
#pragma unroll
                for (int n = 0; n < 2; ++n) {
                    const f32x4 hg = acc[ai][0][m][n] * r, hu = acc[ai][1][m][n] * r;
#pragma unroll
                    for (int i = 0; i < 4; ++i) { const float e = __builtin_amdgcn_exp2f(hg[i] * -1.4426950408889634f); a[n][i] = hg[i] * __builtin_amdgcn_rcpf(1.0f + e) * hu[i]; }
                }
                *(u32x4*)(ACT + (size_t)(u.pm * BM + rt) * 512 + u.pn * 128 + wc * 32 + 8 * fq) = pack8(a[0], a[1]);
            }
    }
};

struct EpiY {
    bf16_t* Y;
    __device__ __forceinline__ void operator()(const f32x4 (&acc)[2][2][4][2], const Unit& u, int wr, int wc, int fr, int fq) const {
        const int row0 = u.pm * BM + wr * 64 + fr, col0 = u.pn * BM + wc * 32 + 8 * fq;
#pragma unroll
        for (int ai = 0; ai < 2; ++ai)
#pragma unroll
            for (int m = 0; m < 4; ++m) {
                bf16_t* rowp = Y + (size_t)(row0 + ai * HALF + m * 16) * 1024 + col0;
#pragma unroll
                for (int bj = 0; bj < 2; ++bj) *(u32x4*)(rowp + bj * HALF) = pack8(acc[ai][bj][m][0], acc[ai][bj][m][1]);
            }
    }
};
}
namespace attn_body {
using bf16=__hip_bfloat16;
using bf16x8=__attribute__((ext_vector_type(8)))short;
using s16x4=__attribute__((ext_vector_type(4)))short;
using f32x16=__attribute__((ext_vector_type(16)))float;
using f32x4=__attribute__((ext_vector_type(4)))float;
using u32x4=__attribute__((ext_vector_type(4)))unsigned;
constexpr int SEQ=4096,D=64,DMI=512;
constexpr int NW=8,QBLK=32,QB=QBLK*NW,KVBLK=64,NQB=SEQ/QB;
__device__ __forceinline__ int crow(int r,int hi){return (r&3)+8*(r>>2)+4*hi;}
#define SBAR() __builtin_amdgcn_sched_barrier(0)
__device__ __forceinline__ void cmask(f32x16&p0,f32x16&p1,int jb,int qrel,int hi){
  const float NEG=-INFINITY; int kb=64*jb+4*hi;
  #pragma unroll
  for(int r=0;r<16;++r){int kv=kb+(r&3)+8*(r>>2); if(kv>qrel)p0[r]=NEG; if(kv+32>qrel)p1[r]=NEG;}
}
__device__ __forceinline__ void kmask(f32x16&p0,f32x16&p1,int jb,int wid){
  const float NEG=-INFINITY;
  if(jb>(wid>>1)){
    #pragma unroll
    for(int r=0;r<16;++r){p0[r]=NEG;p1[r]=NEG;}
  }
}

constexpr int NSLOT=3, SLOTB=8192;
constexpr int LDS_K=0, LDS_V=NSLOT*SLOTB, LDS_WS=2*NSLOT*SLOTB, LDS_OST=LDS_WS+NW*64*4, LDS_GL=LDS_OST+NW*4096, LDS_BYTES=LDS_GL+SEQ*4;
constexpr float C2=0.125f*1.4426950408889634f;
__device__ __forceinline__ void glds16(const void*gsrc,unsigned lds_dst){unsigned keep;
  asm volatile("s_mov_b32 %0, m0\n\ts_mov_b32 m0, %2\n\ts_nop 0\n\tglobal_load_lds_dwordx4 %1, off\n\ts_mov_b32 m0, %0":"=&s"(keep):"v"(gsrc),"s"(lds_dst):"memory");}
__device__ __forceinline__ float max3f(float a,float b,float c){float r;asm("v_max3_f32 %0, %1, %2, %3":"=v"(r):"v"(a),"v"(b),"v"(c));return r;}
__device__ __forceinline__ float max2f(float a,float b){float r;asm("v_max_f32_e32 %0, %1, %2":"=v"(r):"v"(a),"v"(b));return r;}
__device__ __forceinline__ float fsub_s(float a,float b){float r;asm("v_sub_f32_e32 %0, %1, %2":"=v"(r):"v"(a),"v"(b));return r;}
typedef float f32x2_t __attribute__((ext_vector_type(2))); typedef __bf16 bf16x2_t __attribute__((ext_vector_type(2)));
__device__ __forceinline__ unsigned cvtpk_s(float lo,float hi){f32x2_t v={lo,hi};bf16x2_t b=__builtin_convertvector(v,bf16x2_t);return __builtin_bit_cast(unsigned,b);}
__device__ __forceinline__ float bf_lo(unsigned w){return __uint_as_float(w<<16);} __device__ __forceinline__ float bf_hi(unsigned w){return __uint_as_float(w&0xffff0000u);}
#define WAIT_BAR(N) asm volatile("s_waitcnt vmcnt(" #N ") lgkmcnt(0)\n\ts_barrier":::"memory")

__device__ __forceinline__ void qkt(f32x16&p0,f32x16&p1,const char*Kslot,const bf16x8*qr,const f32x16&c0,const f32x16&c1,int r32,int hi){
  const char*kb=Kslot+hi*1024+r32*16;
  #pragma unroll
  for(int d0=0;d0<4;++d0){
    const bf16x8 b0=*reinterpret_cast<const bf16x8*>(kb+d0*2048);
    const bf16x8 b1=*reinterpret_cast<const bf16x8*>(kb+d0*2048+512);
    if(d0==0){p0=__builtin_amdgcn_mfma_f32_32x32x16_bf16(b0,qr[0],c0,0,0,0);p1=__builtin_amdgcn_mfma_f32_32x32x16_bf16(b1,qr[0],c1,0,0,0);}
    else{p0=__builtin_amdgcn_mfma_f32_32x32x16_bf16(b0,qr[d0],p0,0,0,0);p1=__builtin_amdgcn_mfma_f32_32x32x16_bf16(b1,qr[d0],p1,0,0,0);}}
}
typedef __attribute__((address_space(3))) const char* lds_cptr;
typedef short v4i16_t __attribute__((ext_vector_type(4)));
__device__ __forceinline__ void kload8(bf16x8*kf,lds_cptr kp){
  kf[0]=*(const __attribute__((address_space(3))) bf16x8*)(kp);      kf[1]=*(const __attribute__((address_space(3))) bf16x8*)(kp+512);
  kf[2]=*(const __attribute__((address_space(3))) bf16x8*)(kp+2048); kf[3]=*(const __attribute__((address_space(3))) bf16x8*)(kp+2560);
  kf[4]=*(const __attribute__((address_space(3))) bf16x8*)(kp+4096); kf[5]=*(const __attribute__((address_space(3))) bf16x8*)(kp+4608);
  kf[6]=*(const __attribute__((address_space(3))) bf16x8*)(kp+6144); kf[7]=*(const __attribute__((address_space(3))) bf16x8*)(kp+6656);
}
__device__ __forceinline__ void kload2(bf16x8*kf,lds_cptr kp,int j){ kf[2*j]=*(const __attribute__((address_space(3))) bf16x8*)(kp+j*2048); kf[2*j+1]=*(const __attribute__((address_space(3))) bf16x8*)(kp+j*2048+512); }
__device__ __forceinline__ s16x4 vtr(lds_cptr p){ return __builtin_bit_cast(s16x4,__builtin_amdgcn_ds_read_tr16_b64_v4i16((__attribute__((address_space(3))) v4i16_t*)p)); }
typedef __attribute__((address_space(3))) const float* lds_fptr;
__device__ __forceinline__ void bias_tuples(f32x16&c0,f32x16&c1,lds_fptr glt,int hi,float nmh){
  #pragma unroll
  for(int g=0;g<4;++g){
    const f32x4 a=*(const __attribute__((address_space(3))) f32x4*)(glt+8*g+4*hi);
    const f32x4 b=*(const __attribute__((address_space(3))) f32x4*)(glt+32+8*g+4*hi);
    #pragma unroll
    for(int i=0;i<4;++i){c0[4*g+i]=a[i]+nmh;c1[4*g+i]=b[i]+nmh;}
  }
}
__device__ __forceinline__ float rowmax(const f32x16&p0,const f32x16&p1){
  float a=max3f(p0[0],p0[1],p1[0]),b=max3f(p0[2],p0[3],p1[1]);a=max3f(a,p1[2],p1[3]);
  #pragma unroll
  for(int r=4;r<16;r+=4){a=max3f(a,p0[r],p0[r+1]);b=max3f(b,p0[r+2],p0[r+3]);a=max3f(a,p1[r],p1[r+1]);b=max3f(b,p1[r+2],p1[r+3]);}
  const float m=max2f(a,b);
  auto rr=__builtin_amdgcn_permlane32_swap(__float_as_uint(m),__float_as_uint(m),false,false);
  return max2f(__uint_as_float(rr[0]),__uint_as_float(rr[1]));
}
__device__ __forceinline__ void pv(f32x16*o,int vb,bf16x8 pa0,bf16x8 pa1,bf16x8 pa2,bf16x8 pa3){
  #pragma unroll
  for(int d0=0;d0<2;++d0){s16x4 lo[4],hi[4];
    #pragma unroll
    for(int ks=0;ks<4;++ks){
      asm volatile("ds_read_b64_tr_b16 %0,%1 offset:%c2":"=&v"(lo[ks]):"v"(vb),"i"(d0*4096+ks*1024):"memory");
      asm volatile("ds_read_b64_tr_b16 %0,%1 offset:%c2":"=&v"(hi[ks]):"v"(vb),"i"(d0*4096+ks*1024+512):"memory");}
    asm volatile("s_waitcnt lgkmcnt(0)":::"memory");SBAR();
    #define PK(k) (bf16x8){lo[k][0],lo[k][1],lo[k][2],lo[k][3],hi[k][0],hi[k][1],hi[k][2],hi[k][3]}
    o[d0]=__builtin_amdgcn_mfma_f32_32x32x16_bf16(pa0,PK(0),o[d0],0,0,0);
    o[d0]=__builtin_amdgcn_mfma_f32_32x32x16_bf16(pa1,PK(1),o[d0],0,0,0);
    o[d0]=__builtin_amdgcn_mfma_f32_32x32x16_bf16(pa2,PK(2),o[d0],0,0,0);
    o[d0]=__builtin_amdgcn_mfma_f32_32x32x16_bf16(pa3,PK(3),o[d0],0,0,0);
    #undef PK
  }
}

template<int MODE,int THRL> __device__ __forceinline__ void attn_unit(long rowbase,int qb,const bf16*Q,const bf16*__restrict__ K,const bf16*__restrict__ V,bf16*O,int opitch,const float*glp,float lam,float*ssp,char*shm){
  int tid_=threadIdx.x; asm volatile("":"+v"(tid_));
  const int tid=tid_,lane=tid&63,r32=lane&31,hi=lane>>5; const int wid=__builtin_amdgcn_readfirstlane(tid>>6);
  const int q0=qb*QB;
  const bf16*Qw=Q+(rowbase+q0+wid*QBLK)*DMI;
  const bf16*Kh=K+rowbase*DMI,*Vh=V+rowbase*DMI;
  const unsigned lds0=(unsigned)(uintptr_t)shm;
  float*wsf=(float*)(shm+LDS_WS)+wid*64;
  const int NT=(q0+QB)/KVBLK;
  const lds_cptr shm3=(lds_cptr)shm;
  const lds_fptr glt0=(lds_fptr)(shm3+LDS_GL);
  if constexpr(MODE==0){
    __attribute__((address_space(3))) f32x4* gd=(__attribute__((address_space(3))) f32x4*)(shm3+LDS_GL);
    const int n4=(q0+QB)>>2;
    for(int i=tid;i<n4;i+=NW*64){ const f32x4 v=*(const f32x4*)(glp+4*i); gd[i]=v; }
  }
  const bf16*ksrc=Kh+(long)lane*DMI+wid*8;
  const bf16*vsrc=Vh+(long)(16*(wid&3)+(lane>>2))*DMI+(wid>>2)*32+(lane&3)*8;
  const unsigned kdst=lds0+LDS_K+wid*1024, vdst=lds0+LDS_V+wid*1024;
  #define DMA_K(t,slot) glds16(ksrc+(long)(t)*KVBLK*DMI,(unsigned)__builtin_amdgcn_readfirstlane(kdst+(slot)))
  #define DMA_V(t,slot) glds16(vsrc+(long)(t)*KVBLK*DMI,(unsigned)__builtin_amdgcn_readfirstlane(vdst+(slot)))
  const int vb0=(int)(lds0+LDS_V)+((lane>>4)&1)*32+(lane&3)*8+(4*hi+((lane&15)>>2))*64;
  const char*Kbase=shm+LDS_K; bf16x8 kf[8];
  const lds_cptr kp0=shm3+LDS_K+hi*1024+r32*16; const lds_cptr vp0=shm3+LDS_V+((lane>>4)&1)*32+(lane&3)*8+(4*hi+((lane&15)>>2))*64;
  DMA_K(0,0);DMA_V(0,0);DMA_K(1,SLOTB);
  bf16x8 qr[4];
  #pragma unroll
  for(int d0=0;d0<4;++d0)qr[d0]=*reinterpret_cast<const bf16x8*>(&Qw[(long)r32*DMI+d0*16+hi*8]);
  float mhat=0.f,l_reg=0.f;f32x16 o[2];o[0]=f32x16{};o[1]=f32x16{};f32x16 negm=f32x16{};asm volatile("":"+v"(negm));
  float nmh=0.f;
  const int qrel=wid*QBLK+r32;
  #define CMASK(P0,P1,t) do{int jb_=(t)-(NT-4); if(jb_>=0){ if constexpr(MODE==0)cmask(P0,P1,jb_,qrel,hi); else kmask(P0,P1,jb_,wid);} }while(0)
  bool resc=false;
  #define SETREF() do{ if constexpr(MODE==0){ nmh=-mhat; } else { _Pragma("unroll") for(int r=0;r<16;++r)negm[r]=-mhat; asm volatile("":"+v"(negm)); } }while(0)
  #define START(P0,P1) do{ const float rm=rowmax(P0,P1); resc=false; \
    { const float dl=rm; mhat=mhat+dl; \
      _Pragma("unroll") for(int r=0;r<16;++r){P0[r]=fsub_s(P0[r],dl);P1[r]=fsub_s(P1[r],dl);} \
      SETREF(); } \
    _Pragma("unroll") for(int r=0;r<16;++r)P0[r]=__builtin_amdgcn_exp2f(P0[r]); }while(0)
  #define RESC() do{ if(resc){ asm volatile("s_waitcnt lgkmcnt(0)":::"memory"); \
      _Pragma("unroll") for(int d_=0;d_<2;++d_) _Pragma("unroll") for(int r=0;r<16;++r)o[d_][r]*=wsf[crow(r,hi)]; } }while(0)
  f32x16 pA0,pA1,pB0,pB1;
  int sl_prev=0,sl_cur=0,sl_next=SLOTB;
  #define ROT() do{sl_prev=sl_cur;sl_cur=sl_next;sl_next=(sl_next==(NSLOT-1)*SLOTB)?0:sl_next+SLOTB;}while(0)
  DMA_K(2,2*SLOTB);
  WAIT_BAR(3);
  if constexpr(MODE==0){ f32x16 c0,c1; bias_tuples(c0,c1,glt0,hi,0.f); qkt(pA0,pA1,Kbase,qr,c0,c1,r32,hi); }
  else qkt(pA0,pA1,Kbase,qr,negm,negm,r32,hi);
  asm volatile("s_nop 15\n\ts_nop 7":"+v"(pA0),"+v"(pA1));CMASK(pA0,pA1,0);
  START(pA0,pA1);
  _Pragma("unroll") for(int r=0;r<16;++r)pA1[r]=__builtin_amdgcn_exp2f(pA1[r]);
  WAIT_BAR(0);
  DMA_K(3,0);DMA_V(1,SLOTB);
  ROT();
  kload8(kf,kp0+sl_cur);
  WAIT_BAR(2);
  s16x4 vlo[8],vhi[8]; u32x4 pw0,pw1,pw2,pw3;
  #define PKW(P,B) cvtpk_s(P[B],P[B+1])
  #define PAF(k) __builtin_bit_cast(bf16x8,pw##k)
  #define VFR(i) (bf16x8){vlo[i][0],vlo[i][1],vlo[i][2],vlo[i][3],vhi[i][0],vhi[i][1],vhi[i][2],vhi[i][3]}
  #define PIN(x) asm volatile("":"+v"(x))
  #define MX3(a,b,c) __builtin_fmaxf(__builtin_fmaxf((a),(b)),(c))
  #define GAPA(MF,A0,A1,A2,A3,W0,W1,PW) do{ MF; sacc+=A0; sacc+=A1; sacc+=A2; sacc+=A3; PIN(sacc); W0; W1; PIN(PW); SBAR(); }while(0)
  #define EX(v) __builtin_amdgcn_exp2f(v)
  #define GAPB(MF,X,B) do{ MF; X[B]=EX(X[B]); X[B+1]=EX(X[B+1]); X[B+2]=EX(X[B+2]); X[B+3]=EX(X[B+3]); PIN(X); SBAR(); }while(0)
  #define VRD(i) do{ vlo[i]=vtr(vp_+(((i)>>2)*4096+((i)&3)*1024)); vhi[i]=vtr(vp_+(((i)>>2)*4096+((i)&3)*1024+512)); }while(0)
  #define KRD(G,j) do{ if(G){ kload2(kf,kp0+sl_next,j); SBAR(); } }while(0)
  #define STEP(C0,C1,P0,P1,t,GK,GV,GL) do{ SBAR(); \
    f32x16 ci0_,ci1_; if constexpr(MODE==0){ bias_tuples(ci0_,ci1_,glt0+64*(t),hi,nmh); } else { ci0_=negm; ci1_=negm; } \
    const lds_cptr vp_=vp0+sl_prev; \
    VRD(0); SBAR(); float sacc=(P0[0]+P0[1]); \
    GAPA(C0=__builtin_amdgcn_mfma_f32_32x32x16_bf16(kf[0],qr[0],ci0_,0,0,0), P0[2],P0[3],P0[4],P0[5],     pw0[0]=PKW(P0,0), pw0[1]=PKW(P0,2), pw0); \
    VRD(4); SBAR(); GAPA(C1=__builtin_amdgcn_mfma_f32_32x32x16_bf16(kf[1],qr[0],ci1_,0,0,0), P0[6],P0[7],P0[8],P0[9],     pw0[2]=PKW(P0,4), pw0[3]=PKW(P0,6), pw0); \
    VRD(1); SBAR(); GAPA(C0=__builtin_amdgcn_mfma_f32_32x32x16_bf16(kf[2],qr[1],C0,0,0,0),   P0[10],P0[11],P0[12],P0[13], pw1[0]=PKW(P0,8), pw1[1]=PKW(P0,10), pw1); \
    VRD(5); SBAR(); GAPA(C1=__builtin_amdgcn_mfma_f32_32x32x16_bf16(kf[3],qr[1],C1,0,0,0),   P0[14],P0[15],P1[0],P1[1],   pw1[2]=PKW(P0,12),pw1[3]=PKW(P0,14), pw1); \
    VRD(2); SBAR(); GAPA(C0=__builtin_amdgcn_mfma_f32_32x32x16_bf16(kf[4],qr[2],C0,0,0,0),   P1[2],P1[3],P1[4],P1[5],     pw2[0]=PKW(P1,0), pw2[1]=PKW(P1,2), pw2); \
    VRD(6); SBAR(); GAPA(C1=__builtin_amdgcn_mfma_f32_32x32x16_bf16(kf[5],qr[2],C1,0,0,0),   P1[6],P1[7],P1[8],P1[9],     pw2[2]=PKW(P1,4), pw2[3]=PKW(P1,6), pw2); \
    VRD(3); SBAR(); GAPA(C0=__builtin_amdgcn_mfma_f32_32x32x16_bf16(kf[6],qr[3],C0,0,0,0),   P1[10],P1[11],P1[12],P1[13], pw3[0]=PKW(P1,8), pw3[1]=PKW(P1,10), pw3); \
    VRD(7); SBAR(); GAPA(C1=__builtin_amdgcn_mfma_f32_32x32x16_bf16(kf[7],qr[3],C1,0,0,0),   P1[14],P1[15],0.f,0.f,       pw3[2]=PKW(P1,12),pw3[3]=PKW(P1,14), pw3); \
    l_reg+=sacc; \
    if(GK){DMA_K((t)+3,sl_cur);} if(GV){DMA_V((t)+1,sl_next);} \
    CMASK(C0,C1,t); \
    { float a=MX3(C0[0],C0[1],C1[0]),b=MX3(C0[2],C0[3],C1[1]); a=MX3(a,C1[2],C1[3]); \
      _Pragma("unroll") for(int r=4;r<16;r+=4){a=MX3(a,C0[r],C0[r+1]);b=MX3(b,C0[r+2],C0[r+3]);a=MX3(a,C1[r],C1[r+1]);b=MX3(b,C1[r+2],C1[r+3]);} \
      float rm=__builtin_fmaxf(a,b); { auto rr=__builtin_amdgcn_permlane32_swap(__float_as_uint(rm),__float_as_uint(rm),false,false); rm=__builtin_fmaxf(__uint_as_float(rr[0]),__uint_as_float(rr[1])); } \
      resc=false; \
      if(__builtin_expect(__any(rm>(float)THRL),0)){ const float dl=__builtin_fmaxf(rm,0.f); mhat+=dl; \
        _Pragma("unroll") for(int r=0;r<16;++r){C0[r]-=dl;C1[r]-=dl;} \
        SETREF(); \
        const float f=__builtin_amdgcn_exp2f(-dl); l_reg*=f; if(hi==0)wsf[r32]=f; resc=true; } } \
    SBAR(); \
    GAPB(o[0]=__builtin_amdgcn_mfma_f32_32x32x16_bf16(PAF(0),VFR(0),o[0],0,0,0), C0,0); \
    GAPB(o[1]=__builtin_amdgcn_mfma_f32_32x32x16_bf16(PAF(0),VFR(4),o[1],0,0,0), C0,4); \
    KRD(GL,0); GAPB(o[0]=__builtin_amdgcn_mfma_f32_32x32x16_bf16(PAF(1),VFR(1),o[0],0,0,0), C0,8); \
    KRD(GL,1); GAPB(o[1]=__builtin_amdgcn_mfma_f32_32x32x16_bf16(PAF(1),VFR(5),o[1],0,0,0), C0,12); \
    KRD(GL,2); GAPB(o[0]=__builtin_amdgcn_mfma_f32_32x32x16_bf16(PAF(2),VFR(2),o[0],0,0,0), C1,0); \
    KRD(GL,3); GAPB(o[1]=__builtin_amdgcn_mfma_f32_32x32x16_bf16(PAF(2),VFR(6),o[1],0,0,0), C1,4); \
    GAPB(o[0]=__builtin_amdgcn_mfma_f32_32x32x16_bf16(PAF(3),VFR(3),o[0],0,0,0), C1,8); \
    GAPB(o[1]=__builtin_amdgcn_mfma_f32_32x32x16_bf16(PAF(3),VFR(7),o[1],0,0,0), C1,12); \
    }while(0)
  int t=1;
  #undef CMASK
  #define CMASK(P0,P1,t) do{}while(0)
  for(;t+5<NT;t+=2){
    STEP(pB0,pB1,pA0,pA1,t,true,true,true);     WAIT_BAR(2); RESC(); ROT();
    STEP(pA0,pA1,pB0,pB1,t+1,true,true,true);   WAIT_BAR(2); RESC(); ROT();
  }
  #undef CMASK
  #define CMASK(P0,P1,t) do{int jb_=(t)-(NT-4); if(jb_>=0){ if constexpr(MODE==0)cmask(P0,P1,jb_,qrel,hi); else kmask(P0,P1,jb_,wid);} }while(0)
  #define ENDW(tt) do{ if((tt)+3<NT){WAIT_BAR(2);} else if((tt)+2<NT){WAIT_BAR(1);} else {WAIT_BAR(0);} }while(0)
  for(;t+1<NT;t+=2){
    STEP(pB0,pB1,pA0,pA1,t,(t+3<NT),(t+1<NT),(t+1<NT));       ENDW(t);   RESC(); ROT();
    STEP(pA0,pA1,pB0,pB1,t+1,(t+4<NT),(t+2<NT),(t+2<NT));     ENDW(t+1); RESC(); ROT();
  }
  STEP(pB0,pB1,pA0,pA1,NT-1,false,false,false); RESC();
  { float sacc=pB0[0]+pB0[1]; _Pragma("unroll") for(int r=2;r<16;++r)sacc+=pB0[r]; _Pragma("unroll") for(int r=0;r<16;++r)sacc+=pB1[r]; l_reg+=sacc;
    pw0=(u32x4){PKW(pB0,0),PKW(pB0,2),PKW(pB0,4),PKW(pB0,6)};pw1=(u32x4){PKW(pB0,8),PKW(pB0,10),PKW(pB0,12),PKW(pB0,14)};pw2=(u32x4){PKW(pB1,0),PKW(pB1,2),PKW(pB1,4),PKW(pB1,6)};pw3=(u32x4){PKW(pB1,8),PKW(pB1,10),PKW(pB1,12),PKW(pB1,14)};
    SBAR(); pv(o,vb0+sl_cur,PAF(0),PAF(1),PAF(2),PAF(3)); }
  #undef PKW
  #undef PAF
  #undef VFR
  #undef PIN
  #undef MX3
  #undef GAPA
  #undef GAPB
  #undef EX
  #undef VRD
  #undef KRD
  #undef STEP
  #undef ENDW
  {auto rr=__builtin_amdgcn_permlane32_swap(__float_as_uint(l_reg),__float_as_uint(l_reg),false,false);l_reg=__uint_as_float(rr[0])+__uint_as_float(rr[1]);}
  if(hi==0)wsf[32+r32]=l_reg;asm volatile("s_waitcnt lgkmcnt(0)":::"memory");
  float rli[16];
  #pragma unroll
  for(int r=0;r<16;++r)rli[r]=__builtin_amdgcn_rcpf(wsf[32+crow(r,hi)]);
  bf16*Ow=O+(rowbase+q0+wid*QBLK)*(long)opitch;
  { bf16*stg=(bf16*)(shm+LDS_OST)+wid*2048;
    #pragma unroll
    for(int r=0;r<16;++r){const int orow=crow(r,hi);
      #pragma unroll
      for(int d0=0;d0<2;++d0){
        float val=o[d0][r]*rli[r];
        if constexpr(MODE==2){ val=__bfloat162float(stg[orow*64+d0*32+r32])-lam*val; }
        stg[orow*64+d0*32+r32]=__float2bfloat16(val);}}
    asm volatile("s_waitcnt lgkmcnt(0)":::"memory");
    if constexpr(MODE!=1){
      #pragma unroll
      for(int i=0;i<4;++i){const int row=i*8+(lane>>3),ch=lane&7; const u32x4 v=*(const u32x4*)(stg+row*64+ch*8);
        if constexpr(MODE==2){
          float s=0.f;
          #pragma unroll
          for(int j=0;j<4;++j){const float a=bf_lo(v[j]),b=bf_hi(v[j]); s+=a*a+b*b;}
          s+=__shfl_xor(s,1); s+=__shfl_xor(s,2); s+=__shfl_xor(s,4);
          if(ch==0)ssp[(rowbase+q0+wid*QBLK+row)*8]=s;
        }
        *(u32x4*)(Ow+(long)row*opitch+ch*8)=v;} }
  }
  asm volatile("s_waitcnt lgkmcnt(0)\n\ts_barrier":::"memory");
  #undef DMA_K
  #undef DMA_V
  #undef CMASK
  #undef START
  #undef SETREF
  #undef RESC
  #undef ROT
}
#undef SBAR
#undef WAIT_BAR
}
#ifndef REPMASK
#define REPMASK 0
#endif
#define REPS(k) (((REPMASK) >> (k)) & 1 ? 2 : 1)
#ifndef AMM
#define AMM 3
#endif
#ifndef PHM
#define PHM 1023
#endif
constexpr int NWAVES = 8;
constexpr int BATCH = 4, SEQ = 4096, DM = 1024, M = BATCH * SEQ;
constexpr int DIN = 3080, NPROJ = 3072, NEXP = 16, DEXP = 512, LISTCAP = 16384;
constexpr float EPS = 1e-6f, LOG2E = 1.4426950408889634f;
constexpr float LAM_INIT = 0.2f;

constexpr size_t MiB = 1u << 20;
constexpr size_t WS_CTL = 0, CTL_ZERO_BYTES = 1 * MiB;
constexpr size_t WS_GL = 1 * MiB;
constexpr size_t WS_FLOG = WS_GL + 512 * 1024;
constexpr size_t WS_ROPE = 2 * MiB;
constexpr size_t WS_WR = 3 * MiB;
constexpr size_t WS_SS = 3 * MiB + 256 * 1024;
constexpr size_t WS_WIN = 4 * MiB, WS_WOUT = 10 * MiB, WS_WGU = 12 * MiB, WS_WD = 44 * MiB;
constexpr size_t WS_XN = 60 * MiB;
constexpr size_t WS_DD = 60 * MiB;
constexpr size_t WS_LIST = 76 * MiB;
constexpr size_t WS_TOKI = 77 * MiB;
constexpr size_t WS_TOKW = 77 * MiB + 256 * 1024;
constexpr size_t WS_R2 = 77 * MiB + 384 * 1024;
constexpr size_t WS_QKV = 92 * MiB, QKV_STRIDE = 16 * MiB;
constexpr size_t WS_ACT = 92 * MiB;
constexpr size_t WS_Y = 128 * MiB;
constexpr size_t WS_OA = 188 * MiB;
constexpr size_t WS_X1B = 220 * MiB;
constexpr size_t WS_END = 252 * MiB;
constexpr int CW_TMO = 0, CW_CODE = 1, CW_BAR = 4096, CW_CNT = 8192;
constexpr int RING_OFF = 0, RING_BYTES = 131072;
constexpr int LDSCTL_OFF = RING_BYTES, MISC_OFF = LDSCTL_OFF + 320;
constexpr int LDS_BYTES = 147456;
static_assert(MISC_OFF + 128 <= LDS_BYTES, "LDS map");
static_assert(attn_body::LDS_BYTES <= RING_BYTES, "attention scratch fits the ring region");

#define GAS __attribute__((address_space(1)))
#define LAS __attribute__((address_space(3)))
typedef unsigned short bf16;
typedef unsigned v4u __attribute__((ext_vector_type(4)));
typedef float f32x4 __attribute__((ext_vector_type(4)));
typedef GAS unsigned gu32;
#define RLX_AGENT __ATOMIC_RELAXED, __HIP_MEMORY_SCOPE_AGENT
#define LDS_WAIT() asm volatile("s_waitcnt lgkmcnt(0)" ::: "memory")
#define VM_WAIT() asm volatile("s_waitcnt vmcnt(0)" ::: "memory")
__device__ __forceinline__ unsigned f2bf(float f) { unsigned u = __builtin_bit_cast(unsigned, f); return (u + 0x7fffu + ((u >> 16) & 1u)) >> 16; }
__device__ __forceinline__ unsigned pk2(float lo, float hi) { return f2bf(lo) | (f2bf(hi) << 16); }
__device__ __forceinline__ float bflo(unsigned w) { return __uint_as_float(w << 16); }
__device__ __forceinline__ float bfhi(unsigned w) { return __uint_as_float(w & 0xffff0000u); }

#define XB_TMO      128
#define XB_XCNT(j)  (256  + 64 * (j))
#define XB_XSUB(j)  (1280 + 64 * (j))
#define XB_XGEN(j)  (2304 + 64 * (j))
#define XB_TOP      3328
#define XB_TOPGEN   3392
#define XCD_BAR_WORDS 3456
#define XB_SPIN_CAP (1u << 18)
__device__ __forceinline__ unsigned xb_ld(unsigned* p)              { return __hip_atomic_load(p, __ATOMIC_RELAXED, __HIP_MEMORY_SCOPE_AGENT); }
__device__ __forceinline__ unsigned xb_add(unsigned* p, unsigned v) { return __hip_atomic_fetch_add(p, v, __ATOMIC_RELAXED, __HIP_MEMORY_SCOPE_AGENT); }
__device__ __forceinline__ unsigned xb_xcc_id() { return (unsigned)__builtin_amdgcn_s_getreg((3 << 11) | 20) & 0xFu; }
#define XB_SPIN(cond, bar) do { unsigned _sp = 0; while (cond) { __builtin_amdgcn_s_sleep(1); \
    if ((++_sp & 255u) == 0u) { if (xb_ld(&(bar)[XB_TMO])) break; if (_sp > XB_SPIN_CAP) { atomicAdd(&(bar)[XB_TMO], 1u); break; } } } } while (0)
struct XcdBarrier { unsigned* bar; unsigned x; volatile LAS unsigned* st; };
__device__ __forceinline__ XcdBarrier xcd_barrier_post(unsigned* bar, volatile LAS unsigned* st) {
    XcdBarrier b; b.bar = bar; b.x = xb_xcc_id(); b.st = st;
    if (threadIdx.x == 0) (void)xb_add(&bar[XB_XCNT(b.x)], 1u);
    return b;
}
__device__ __forceinline__ void xcd_barrier_complete(unsigned* bar, unsigned x, unsigned& nloc, unsigned& nx) {
    const unsigned G = gridDim.x * gridDim.y * gridDim.z;
    unsigned sum, cnt, mine, sp = 0u;
    for (;;) {
        sum = 0u; cnt = 0u; mine = 0u;
#pragma unroll
        for (unsigned j = 0; j < 16; ++j) { const unsigned c = xb_ld(&bar[XB_XCNT(j)]); sum += c; cnt += (c > 0u) ? 1u : 0u; mine = (j == x) ? c : mine; }
        if (sum == G) break;
        __builtin_amdgcn_s_sleep(1);
        if ((++sp & 255u) == 0u) { if (xb_ld(&bar[XB_TMO])) break; if (sp > XB_SPIN_CAP) { atomicAdd(&bar[XB_TMO], 1u); break; } }
    }
    nloc = mine > 0u ? mine : 1u; nx = cnt > 0u ? cnt : 1u;
}
__device__ __forceinline__ void xcd_barrier(const XcdBarrier& b) {
    asm volatile("s_waitcnt vmcnt(0)" ::: "memory");
    __syncthreads();
    if (threadIdx.x == 0) {
        unsigned* bar = b.bar;
        __builtin_amdgcn_s_waitcnt(0);
        unsigned nloc = b.st[0], nx = b.st[1];
        if (nloc == 0u) { xcd_barrier_complete(bar, b.x, nloc, nx); b.st[0] = nloc; b.st[1] = nx; }
        const unsigned old = xb_add(&bar[XB_XSUB(b.x)], 1u);
        const unsigned gen = old / nloc;
        if (old + 1u == (gen + 1u) * nloc) {
            __builtin_amdgcn_fence(__ATOMIC_RELEASE, "agent");
            asm volatile("s_waitcnt vmcnt(0)" ::: "memory");
            const unsigned og = xb_add(&bar[XB_TOP], 1u);
            const unsigned tg = og / nx;
            if (og + 1u == (tg + 1u) * nx) xb_add(&bar[XB_TOPGEN], 1u);
            else XB_SPIN(xb_ld(&bar[XB_TOPGEN]) == tg, bar);
            __builtin_amdgcn_fence(__ATOMIC_ACQUIRE, "agent");
            xb_add(&bar[XB_XGEN(b.x)], 1u);
            asm volatile("s_waitcnt vmcnt(0)" ::: "memory");
        } else {
            XB_SPIN(xb_ld(&bar[XB_XGEN(b.x)]) == gen, bar);
            __builtin_amdgcn_fence(__ATOMIC_ACQUIRE, "agent");
            asm volatile("s_waitcnt vmcnt(0)" ::: "memory");
        }
    }
    __syncthreads();
}

struct Args { const float* in[19]; float* out; unsigned char* ws; };

struct Frame {
    LAS unsigned char* lds; volatile LAS unsigned* MISC; gu32* ctl;
    int tid, lane, wave, vcu, G;
};

__device__ __forceinline__ float wave_sum(float v) {
#pragma unroll
    for (int o = 1; o < 64; o <<= 1) v += __shfl_xor(v, o);
    return v;
}

__device__ __forceinline__ void tr_item(const float* W, int ldw, int n0s, int k0, const float* gk, bf16* WT, int K, int dn0, LAS float* scr, int lane) {
#pragma unroll 8
    for (int i = 0; i < 32; ++i) { const int kk = 2 * i + (lane >> 5); float v = W[(size_t)(k0 + kk) * ldw + n0s + (lane & 31)]; if (gk) v *= gk[k0 + kk]; scr[kk * 33 + (lane & 31)] = v; }
    LDS_WAIT(); asm volatile("" ::: "memory");
    const int c = lane & 7;
#pragma unroll
    for (int j = 0; j < 4; ++j) { const int n = (lane >> 3) + 8 * j; const LAS float* s = scr + (8 * c) * 33 + n;
        v4u o; o.x = pk2(s[0 * 33], s[1 * 33]); o.y = pk2(s[2 * 33], s[3 * 33]); o.z = pk2(s[4 * 33], s[5 * 33]); o.w = pk2(s[6 * 33], s[7 * 33]);
        *(GAS v4u*)(WT + (size_t)(dn0 + n) * K + k0 + 8 * c) = o; }
    LDS_WAIT(); asm volatile("" ::: "memory");
}

__device__ __forceinline__ void p0_prologue(Frame& F, const Args& a) {
    unsigned char* ws = a.ws;
    const float* x = a.in[0]; const float* g_attn = a.in[1]; const float* w_in = a.in[2]; const float* b_forget = a.in[3];
    const float* w_out = a.in[9]; const float* g_ffn = a.in[10]; const float* wr_g = a.in[11]; const float* wr_e = a.in[13];
    const float* w_gate = a.in[15]; const float* w_up = a.in[16]; const float* w_down = a.in[17];
    bf16* WinT = (bf16*)(ws + WS_WIN); bf16* WoutT = (bf16*)(ws + WS_WOUT); bf16* WguT = (bf16*)(ws + WS_WGU); bf16* WdT = (bf16*)(ws + WS_WD);
    LAS float* scr = (LAS float*)(F.lds + RING_OFF + F.wave * 16384);
    const int gw = F.vcu * NWAVES + F.wave, NGW = F.G * NWAVES, lane = F.lane;
    constexpr int I_IN = 16 * 96, I_OUT = 16 * 32, I_GU = 16 * 2 * 16 * 16, I_D = 16 * 8 * 32;
    constexpr int NITEMS = I_IN + I_OUT + I_GU + I_D;
    for (int it = gw; it < NITEMS; it += NGW) {
        int r = it;
        if (r < I_IN) { const int kb = r / 96, nb = r % 96; int dn0;
            if (nb < 32) { const int U = nb >> 1, hf = nb & 1; dn0 = (U >> 2) * 256 + hf * 128 + 32 * (U & 3); } else dn0 = 32 * nb;
            tr_item(w_in, DIN, 32 * nb, 64 * kb, g_attn, WinT, DM, dn0, scr, lane); continue; } r -= I_IN;
        if (r < I_OUT) { const int kb = r / 32, nb = r % 32; tr_item(w_out, DM, 32 * nb, 64 * kb, nullptr, WoutT, DM, 32 * nb, scr, lane); continue; } r -= I_OUT;
        if (r < I_GU) { const int e = r / 512, q = r % 512, up = q / 256, q2 = q % 256, kb = q2 / 16, nb = q2 % 16;
            const float* W = (up ? w_up : w_gate) + (size_t)e * DM * DEXP;
            tr_item(W, DEXP, 32 * nb, 64 * kb, g_ffn, WguT, DM, e * 1024 + (nb >> 2) * 256 + up * 128 + (nb & 3) * 32, scr, lane); continue; } r -= I_GU;
        { const int e = r / 256, q = r % 256, kb = q / 32, nb = q % 32;
            tr_item(w_down + (size_t)e * DEXP * DM, DM, 32 * nb, 64 * kb, nullptr, WdT, DEXP, e * 1024 + 32 * nb, scr, lane); }
    }
    {
        const int gt = F.vcu * (NWAVES * 64) + F.tid, NGT = F.G * NWAVES * 64;
        float* rope = (float*)(ws + WS_ROPE);
        for (int i = gt; i < 4096 * 32; i += NGT) { const int pos = i >> 5, j = i & 31;
            const float inv = 1.0f / powf(10000.0f, (float)(2 * j) / 64.0f); const float ang = (float)pos * inv;
            float s, c; sincosf(ang, &s, &c); rope[pos * 64 + j] = c; rope[pos * 64 + 32 + j] = s; }
        float* WR = (float*)(ws + WS_WR);
        for (int i = gt; i < 1024 * 32; i += NGT) { const int k = i >> 5, j = i & 31; float v = 0.f;
            if (j < 4) v = wr_g[k * 4 + j] * g_ffn[k]; else if (j < 20) v = wr_e[k * 16 + (j - 4)] * g_ffn[k];
            WR[i] = v; }
    }
    {
        f32x4 wf[16][2];
#pragma unroll
        for (int jj = 0; jj < 4; ++jj)
#pragma unroll
            for (int c = 0; c < 4; ++c) { const int k = 4 * lane + c + 256 * jj; const float gk = g_attn[k]; const float* wp = w_in + (size_t)k * DIN + NPROJ;
                wf[jj * 4 + c][0] = *(const f32x4*)(wp) * gk; wf[jj * 4 + c][1] = *(const f32x4*)(wp + 4) * gk; }
        bf16* XN = (bf16*)(ws + WS_XN); float* FLOG = (float*)(ws + WS_FLOG);
        for (int m = gw; m < M; m += NGW) {
            const GAS f32x4* xr = (const GAS f32x4*)(x + (size_t)m * DM) + lane;
            f32x4 v[4]; float s2 = 0.f;
#pragma unroll
            for (int j = 0; j < 4; ++j) { v[j] = xr[64 * j]; s2 += (v[j].x * v[j].x + v[j].y * v[j].y) + (v[j].z * v[j].z + v[j].w * v[j].w); }
            const float rstd = 1.0f / sqrtf(wave_sum(s2) * (1.f / DM) + EPS);
            f32x4 d0 = (f32x4){0.f, 0.f, 0.f, 0.f}, d1 = d0;
#pragma unroll
            for (int j = 0; j < 4; ++j)
#pragma unroll
                for (int c = 0; c < 4; ++c) { d0 += wf[j * 4 + c][0] * v[j][c]; d1 += wf[j * 4 + c][1] * v[j][c]; }
            float fl = 0.f;
#pragma unroll
            for (int q = 0; q < 4; ++q) { const float a0 = wave_sum(d0[q]), a1 = wave_sum(d1[q]); if (lane == q) fl = a0; if (lane == 4 + q) fl = a1; }
            if (lane < 8) { const float z = fl * rstd + b_forget[lane]; const float az = fabsf(z);
                const float lf = fminf(z, 0.f) - log1pf(expf(-az));
                const int b = m >> 12, t = m & 4095; FLOG[(b * 8 + lane) * 4096 + t] = lf; }
            GAS unsigned long long* o8 = (GAS unsigned long long*)(XN + (size_t)m * DM) + lane;
#pragma unroll
            for (int j = 0; j < 4; ++j) o8[64 * j] = (unsigned long long)pk2(v[j].x * rstd, v[j].y * rstd) | ((unsigned long long)pk2(v[j].z * rstd, v[j].w * rstd) << 32);
        }
    }
}

__device__ __forceinline__ void p1_scan(Frame& F, const Args& a) {
    const float* FLOG = (const float*)(a.ws + WS_FLOG); float* GLo = (float*)(a.ws + WS_GL);
    LAS float* wsum = (LAS float*)(F.lds + RING_OFF);
    for (int bh = blockIdx.x; bh < 32; bh += F.G) {
        const f32x4* src = (const f32x4*)(FLOG + bh * 4096 + F.tid * 8);
        f32x4 u0 = src[0], u1 = src[1];
        float p[8]; p[0] = u0.x; p[1] = p[0] + u0.y; p[2] = p[1] + u0.z; p[3] = p[2] + u0.w; p[4] = p[3] + u1.x; p[5] = p[4] + u1.y; p[6] = p[5] + u1.z; p[7] = p[6] + u1.w;
        float incl = p[7];
#pragma unroll
        for (int o = 1; o < 64; o <<= 1) { const float nb = __shfl_up(incl, o); if (F.lane >= o) incl += nb; }
        if (F.lane == 63) wsum[F.wave] = incl;
        LDS_WAIT(); __syncthreads();
        float base = incl - p[7];
        for (int w = 0; w < F.wave; ++w) base += wsum[w];
        f32x4 o0, o1; o0.x = -LOG2E * (base + p[0]); o0.y = -LOG2E * (base + p[1]); o0.z = -LOG2E * (base + p[2]); o0.w = -LOG2E * (base + p[3]);
        o1.x = -LOG2E * (base + p[4]); o1.y = -LOG2E * (base + p[5]); o1.z = -LOG2E * (base + p[6]); o1.w = -LOG2E * (base + p[7]);
        f32x4* dst = (f32x4*)(GLo + bh * 4096 + F.tid * 8); dst[0] = o0; dst[1] = o1;
        LDS_WAIT(); __syncthreads();
    }
    VM_WAIT(); __syncthreads();
}

__device__ __forceinline__ void p25_diffnorm(Frame& F, const Args& a) {
    const bf16* DD = (const bf16*)(a.ws + WS_DD); const float* SS = (const float*)(a.ws + WS_SS); bf16* OA = (bf16*)(a.ws + WS_OA); const float* gd = a.in[8];
    const int gt = F.vcu * (NWAVES * 64) + F.tid, NGT = F.G * NWAVES * 64;
    for (int i = gt; i < M * 64; i += NGT) {
        const int tok = i >> 6, ch = i & 63, h = ch >> 4;
        const v4u d = *(const v4u*)(DD + (size_t)tok * 512 + 8 * ch);
        const float ss = SS[tok * 8 + 2 * h] + SS[tok * 8 + 2 * h + 1];
        const float s = (1.0f - LAM_INIT) / sqrtf(ss * (1.f / 128.f) + EPS);
        const float* gp = gd + ((8 * ch) & 127);
        const f32x4 g0 = *(const f32x4*)gp, g1 = *(const f32x4*)(gp + 4);
        v4u o; o.x = pk2(bflo(d.x) * s * g0.x, bfhi(d.x) * s * g0.y); o.y = pk2(bflo(d.y) * s * g0.z, bfhi(d.y) * s * g0.w);
        o.z = pk2(bflo(d.z) * s * g1.x, bfhi(d.z) * s * g1.y); o.w = pk2(bflo(d.w) * s * g1.z, bfhi(d.w) * s * g1.w);
        *(v4u*)(OA + (size_t)tok * 1024 + 8 * ch) = o;
    }
}

__device__ __forceinline__ void p35_route(Frame& F, const Args& a) {
    const bf16* X1B = (const bf16*)(a.ws + WS_X1B); const float* WR = (const float*)(a.ws + WS_WR);
    const float* bg = a.in[12]; const float* be = a.in[14];
    int* LIST = (int*)(a.ws + WS_LIST); int* TOKI = (int*)(a.ws + WS_TOKI); float* TOKW = (float*)(a.ws + WS_TOKW); float* R2 = (float*)(a.ws + WS_R2);
    LAS float* T = (LAS float*)(F.lds + RING_OFF);
    LAS int* lcnt = (LAS int*)(F.lds + RING_OFF + 8 * 64 * 24 * 4);
    for (int tb = F.vcu; tb < M / 64; tb += F.G) {
        const int tok = tb * 64 + F.lane;
        float acc[21];
#pragma unroll
        for (int j = 0; j < 21; ++j) acc[j] = 0.f;
        const bf16* xr = X1B + (size_t)tok * DM + 128 * F.wave;
        const float* wbase = WR + (size_t)(128 * F.wave) * 32;
        for (int kk = 0; kk < 128; kk += 8) {
            const v4u xv = *(const v4u*)(xr + kk);
            float xf[8] = {bflo(xv.x), bfhi(xv.x), bflo(xv.y), bfhi(xv.y), bflo(xv.z), bfhi(xv.z), bflo(xv.w), bfhi(xv.w)};
#pragma unroll
            for (int i = 0; i < 8; ++i) {
                const float* wp = wbase + (kk + i) * 32;
                const f32x4 w0 = *(const f32x4*)(wp), w1 = *(const f32x4*)(wp + 4), w2 = *(const f32x4*)(wp + 8), w3 = *(const f32x4*)(wp + 12), w4 = *(const f32x4*)(wp + 16);
                acc[20] += xf[i] * xf[i];
#pragma unroll
                for (int j = 0; j < 4; ++j) { acc[j] += xf[i] * w0[j]; acc[4 + j] += xf[i] * w1[j]; acc[8 + j] += xf[i] * w2[j]; acc[12 + j] += xf[i] * w3[j]; acc[16 + j] += xf[i] * w4[j]; }
            }
        }
#pragma unroll
        for (int j = 0; j < 21; ++j) T[(F.wave * 64 + F.lane) * 24 + j] = acc[j];
        if (F.tid < 16) lcnt[F.tid] = 0;
        LDS_WAIT(); __syncthreads();
        int e0 = 0, e1 = 0, rk0 = 0, rk1 = 0; float w0 = 0.f, w1 = 0.f;
        if (F.wave == 0) {
            float s[21];
#pragma unroll
            for (int j = 0; j < 21; ++j) { float v = 0.f;
#pragma unroll
                for (int w = 0; w < 8; ++w) v += T[(w * 64 + F.lane) * 24 + j];
                s[j] = v; }
            const float r = 1.0f / sqrtf(s[20] * (1.f / DM) + EPS);
            float gl[4];
#pragma unroll
            for (int j = 0; j < 4; ++j) gl[j] = s[j] * r + bg[j];
            int g = 0; float gm = gl[0];
#pragma unroll
            for (int j = 1; j < 4; ++j) if (gl[j] > gm) { gm = gl[j]; g = j; }
            float den = 0.f;
#pragma unroll
            for (int j = 0; j < 4; ++j) den += expf(gl[j] - gm);
            const float gw = 1.0f / den;
            float el[4];
#pragma unroll
            for (int i = 0; i < 4; ++i) { float v = s[4 + i]; v = (g == 1) ? s[8 + i] : v; v = (g == 2) ? s[12 + i] : v; v = (g == 3) ? s[16 + i] : v;
                float bb = be[i]; bb = (g == 1) ? be[4 + i] : bb; bb = (g == 2) ? be[8 + i] : bb; bb = (g == 3) ? be[12 + i] : bb; el[i] = v * r + bb; }
            int i0 = 0; float v0 = el[0];
#pragma unroll
            for (int i = 1; i < 4; ++i) if (el[i] > v0) { v0 = el[i]; i0 = i; }
            int i1 = -1; float v1 = 0.f;
#pragma unroll
            for (int i = 0; i < 4; ++i) if (i != i0 && (i1 < 0 || el[i] > v1)) { v1 = el[i]; i1 = i; }
            const float p0 = 1.0f / (1.0f + expf(v1 - v0));
            w0 = gw * p0; w1 = gw * (1.0f - p0); e0 = 4 * g + i0; e1 = 4 * g + i1;
            rk0 = __hip_atomic_fetch_add(lcnt + e0, 1, __ATOMIC_RELAXED, __HIP_MEMORY_SCOPE_WORKGROUP);
            rk1 = __hip_atomic_fetch_add(lcnt + e1, 1, __ATOMIC_RELAXED, __HIP_MEMORY_SCOPE_WORKGROUP);
            R2[tok] = r;
        }
        LDS_WAIT(); __syncthreads();
        if (F.tid < 16) { const int n = lcnt[F.tid]; int base = 0; if (n > 0) base = (int)__hip_atomic_fetch_add((unsigned*)(F.ctl + CW_CNT + 64 * F.tid), (unsigned)n, RLX_AGENT); lcnt[16 + F.tid] = base; }
        LDS_WAIT(); __syncthreads();
        if (F.wave == 0) {
            rk0 += lcnt[16 + e0]; rk1 += lcnt[16 + e1];
            LIST[e0 * LISTCAP + (rk0 & (LISTCAP - 1))] = tok; LIST[e1 * LISTCAP + (rk1 & (LISTCAP - 1))] = tok;
            *(int4*)(TOKI + 4 * tok) = make_int4(e0, rk0, e1, rk1);
            *(float2*)(TOKW + 2 * tok) = make_float2(w0, w1);
        }
        LDS_WAIT(); __syncthreads();
    }
}

__device__ __forceinline__ void p6_final(Frame& F, const Args& a) {
    const bf16* X1B = (const bf16*)(a.ws + WS_X1B); const bf16* Y = (const bf16*)(a.ws + WS_Y);
    const int* TOKI = (const int*)(a.ws + WS_TOKI); const float* TOKW = (const float*)(a.ws + WS_TOKW); const float* gf = a.in[18];
    int base[16]; { int acc = 0;
#pragma unroll
        for (int e = 0; e < 16; ++e) { int c = (int)__builtin_amdgcn_readfirstlane(__hip_atomic_load(F.ctl + CW_CNT + 64 * e, RLX_AGENT)); if (c > 16384) c = 16384; base[e] = acc * 256; acc += (c + 255) >> 8; } }
    const int gw = F.vcu * NWAVES + F.wave, NGW = F.G * NWAVES, lane = F.lane;
    f32x4 g4[4];
#pragma unroll
    for (int j = 0; j < 2; ++j) { g4[2 * j] = *(const f32x4*)(gf + 512 * j + 8 * lane); g4[2 * j + 1] = *(const f32x4*)(gf + 512 * j + 8 * lane + 4); }
    for (int m = gw; m < M; m += NGW) {
        const int4 ti = *(const int4*)(TOKI + 4 * m); const float2 tw = *(const float2*)(TOKW + 2 * m);
        const int e0 = __builtin_amdgcn_readfirstlane(ti.x), r0 = __builtin_amdgcn_readfirstlane(ti.y), e1 = __builtin_amdgcn_readfirstlane(ti.z), r1 = __builtin_amdgcn_readfirstlane(ti.w);
        int b0 = 0, b1 = 0;
#pragma unroll
        for (int e = 0; e < 16; ++e) { b0 = (e0 == e) ? base[e] : b0; b1 = (e1 == e) ? base[e] : b1; }
        const bf16* xp = X1B + (size_t)m * DM + 8 * lane; const bf16* y0 = Y + (size_t)(b0 + r0) * DM + 8 * lane; const bf16* y1 = Y + (size_t)(b1 + r1) * DM + 8 * lane;
        float v[16]; float s2 = 0.f;
#pragma unroll
        for (int j = 0; j < 2; ++j) {
            const v4u xv = *(const v4u*)(xp + 512 * j), ya = *(const v4u*)(y0 + 512 * j), yb = *(const v4u*)(y1 + 512 * j);
#pragma unroll
            for (int q = 0; q < 4; ++q) { v[8 * j + 2 * q] = bflo(xv[q]) + tw.x * bflo(ya[q]) + tw.y * bflo(yb[q]); v[8 * j + 2 * q + 1] = bfhi(xv[q]) + tw.x * bfhi(ya[q]) + tw.y * bfhi(yb[q]); }
        }
#pragma unroll
        for (int i = 0; i < 16; ++i) s2 += v[i] * v[i];
        const float rstd = 1.0f / sqrtf(wave_sum(s2) * (1.f / DM) + EPS);
        float* op = a.out + (size_t)m * DM + 8 * lane;
#pragma unroll
        for (int j = 0; j < 2; ++j) {
            f32x4 oa, ob;
#pragma unroll
            for (int q = 0; q < 4; ++q) { oa[q] = v[8 * j + q] * rstd * g4[2 * j][q]; ob[q] = v[8 * j + 4 + q] * rstd * g4[2 * j + 1][q]; }
            *(f32x4*)(op + 512 * j) = oa; *(f32x4*)(op + 512 * j + 4) = ob;
        }
    }
}

__global__ void __launch_bounds__(NWAVES * 64, 2) mk_fwd(Args args) {
    extern __shared__ __attribute__((aligned(16))) unsigned char lds[];
    Frame F;
    F.lds = (LAS unsigned char*)lds;
    F.MISC = (volatile LAS unsigned*)(F.lds + MISC_OFF);
    F.tid = threadIdx.x; F.lane = F.tid & 63; F.wave = __builtin_amdgcn_readfirstlane(F.tid >> 6);
    F.G = gridDim.x; { const int bx = blockIdx.x; F.vcu = (F.G % 8 == 0) ? (bx % 8) * (F.G / 8) + bx / 8 : bx; }
    unsigned char* ws = args.ws;
    F.ctl = (gu32*)(ws + WS_CTL);
    for (int u = F.tid; u < (LDS_BYTES - LDSCTL_OFF) / 4; u += NWAVES * 64) ((LAS unsigned*)(F.lds + LDSCTL_OFF))[u] = 0u;
    __syncthreads();
    XcdBarrier bar = xcd_barrier_post((unsigned*)(F.ctl + CW_BAR), F.MISC + 8);
#define GRID_BAR() xcd_barrier(bar)

    for (int rep = 0; rep < REPS(0); ++rep) p0_prologue(F, args);
    GRID_BAR();

    if (PHM & 2) p1_scan(F, args);
    for (int rep = 0; rep < REPS(1); ++rep) {
        pg8::Gemm g{(const pg8::bf16_t*)(ws + WS_XN), (const pg8::bf16_t*)(ws + WS_WIN), DM};
        pg8::StaticOrder S; S.init(M, NPROJ, F.G, (int)blockIdx.x);
        epi::EpiProj E{(pg8::bf16_t*)(ws + WS_QKV), QKV_STRIDE / 2, (const float*)(ws + WS_ROPE), attn_body::C2};
        pg8::gemm_phase<epi::EpiProj, pg8::StaticOrder, true>(F.lds + RING_OFF, g, S, E);
    }
    GRID_BAR();

    for (int rep = 0; rep < REPS(2); ++rep) {
        using abf = attn_body::bf16;
        const abf* QD = (const abf*)(ws + WS_QKV); const abf* KD = QD + QKV_STRIDE / 2; const abf* VD = KD + QKV_STRIDE / 2;
        const abf* QF = VD + QKV_STRIDE / 2; const abf* KF = QF + QKV_STRIDE / 2; const abf* VF = KF + QKV_STRIDE / 2;
        abf* OA = (abf*)(ws + WS_OA); abf* DDp = (abf*)(ws + WS_DD); float* SS = (float*)(ws + WS_SS); const float* GLp = (const float*)(ws + WS_GL);
        float lam;
        { const float a1 = wave_sum(args.in[4][F.lane] * args.in[5][F.lane]), a2 = wave_sum(args.in[6][F.lane] * args.in[7][F.lane]); lam = expf(a1) - expf(a2) + LAM_INIT; }
        char* shm = (char*)lds + RING_OFF;
        for (int it = F.vcu; it < 512; it += F.G) {
            if ((AMM & 1) && it >= 256) {
                const int dp = it - 256, bh = dp >> 4, hf = (dp >> 3) & 1, s = dp & 7, b = bh >> 2, h = bh & 3;
                const long rowbase = (long)b * SEQ;
                for (int k = 0; k < 2; ++k) { const int qb = k ? s : 15 - s;
                    attn_body::attn_unit<1, 8>(rowbase, qb, QD + h * 128, KD + h * 128, VD + h * 128 + hf * 64, DDp, 512, nullptr, 0.f, nullptr, shm);
                    attn_body::attn_unit<2, 8>(rowbase, qb, QD + h * 128 + 64, KD + h * 128 + 64, VD + h * 128 + hf * 64, DDp + h * 128 + hf * 64, 512, nullptr, lam, SS + h * 2 + hf, shm); }
            } else if (AMM & 2) {
                const int bh = it >> 3, s = it & 7, b = bh >> 3, h = bh & 7;
                const long rowbase = (long)b * SEQ;
                for (int k = 0; k < 2; ++k) { const int qb = k ? s : 15 - s;
                    attn_body::attn_unit<0, 8>(rowbase, qb, QF + h * 64, KF + h * 64, VF + h * 64, OA + 512 + h * 64, 1024, GLp + bh * 4096, 0.f, nullptr, shm); }
            }
        }
    }
    GRID_BAR();

    for (int rep = 0; rep < REPS(3); ++rep) p25_diffnorm(F, args);
    GRID_BAR();

    for (int rep = 0; rep < REPS(4); ++rep) {
        pg8::Gemm g{(const pg8::bf16_t*)(ws + WS_OA), (const pg8::bf16_t*)(ws + WS_WOUT), DM};
        pg8::StaticOrder S; S.init(M, DM, F.G, (int)blockIdx.x);
        epi::EpiRes E{args.in[0], (pg8::bf16_t*)(ws + WS_X1B)};
        pg8::gemm_phase<epi::EpiRes, pg8::StaticOrder, true>(F.lds + RING_OFF, g, S, E);
    }
    GRID_BAR();

    p35_route(F, args);
    GRID_BAR();

    for (int rep = 0; rep < REPS(6); ++rep) {
        pg8::Gemm g{(const pg8::bf16_t*)(ws + WS_X1B), (const pg8::bf16_t*)(ws + WS_WGU), DM};
        pg8::ExpertOrder<true> S; S.init((const unsigned*)(F.ctl + CW_CNT), F.G, (int)blockIdx.x, (const int*)(ws + WS_LIST));
        epi::EpiSwiglu E{(pg8::bf16_t*)(ws + WS_ACT), (const int*)(ws + WS_LIST), (const float*)(ws + WS_R2)};
        pg8::gemm_phase<epi::EpiSwiglu, pg8::ExpertOrder<true>, true>(F.lds + RING_OFF, g, S, E);
    }
    GRID_BAR();

    for (int rep = 0; rep < REPS(7); ++rep) {
        pg8::Gemm g{(const pg8::bf16_t*)(ws + WS_ACT), (const pg8::bf16_t*)(ws + WS_WD), DEXP};
        pg8::ExpertOrder<false> S; S.init((const unsigned*)(F.ctl + CW_CNT), F.G, (int)blockIdx.x, nullptr);
        epi::EpiY E{(pg8::bf16_t*)(ws + WS_Y)};
        pg8::gemm_phase<epi::EpiY, pg8::ExpertOrder<false>, true>(F.lds + RING_OFF, g, S, E);
    }
    GRID_BAR();

    for (int rep = 0; rep < REPS(8); ++rep) p6_final(F, args);
}

extern "C" void kernel_launch(void* const* d_in, const int* in_sizes, int n_in, void* d_out, int out_size, void* d_ws, size_t ws_size, hipStream_t stream) {
    static int grid = 0;
    if (grid == 0) {
        if (n_in != 19 || in_sizes[0] != M * DM || out_size != M * DM || ws_size < WS_END) { fprintf(stderr, "kernel_launch: unexpected shapes (n_in %d, in0 %d, out %d, ws %zu); nothing launched\n", n_in, n_in > 0 ? in_sizes[0] : -1, out_size, ws_size); grid = -1; return; }
        int dev = 0, cus = 0, per_cu = 0;
        if (hipGetDevice(&dev) != hipSuccess || hipDeviceGetAttribute(&cus, hipDeviceAttributeMultiprocessorCount, dev) != hipSuccess) { grid = -1; return; }
        if (hipFuncSetAttribute((const void*)mk_fwd, hipFuncAttributeMaxDynamicSharedMemorySize, LDS_BYTES) != hipSuccess) { fprintf(stderr, "kernel_launch: hipFuncSetAttribute failed\n"); grid = -1; return; }
        if (hipOccupancyMaxActiveBlocksPerMultiprocessor(&per_cu, (const void*)mk_fwd, NWAVES * 64, LDS_BYTES) != hipSuccess || per_cu < 1) { fprintf(stderr, "kernel_launch: occupancy query says %d blocks per CU\n", per_cu); (void)hipGetLastError(); grid = -1; return; }
        grid = cus;
    }
    if (grid < 0) return;
    if (hipMemsetAsync((char*)d_ws + WS_CTL, 0, CTL_ZERO_BYTES, stream) != hipSuccess) { fprintf(stderr, "kernel_launch: hipMemsetAsync failed\n"); return; }
    Args a{};
    for (int i = 0; i < 19; ++i) a.in[i] = (const float*)d_in[i];
    a.out = (float*)d_out; a.ws = (unsigned char*)d_ws;
#ifndef MK_COOP
#define MK_COOP 1
#endif
#if MK_COOP
    void* kargs[] = {&a};
    hipError_t e = hipLaunchCooperativeKernel((const void*)mk_fwd, dim3(grid), dim3(NWAVES * 64), kargs, LDS_BYTES, stream);
    if (e != hipSuccess) fprintf(stderr, "kernel_launch: cooperative launch failed: %s (grid %d)\n", hipGetErrorString(e), grid);
#else
    hipLaunchKernelGGL(mk_fwd, dim3(grid), dim3(NWAVES * 64), LDS_BYTES, stream, a);
    const hipError_t e = hipPeekAtLastError();
    if (e != hipSuccess) fprintf(stderr, "kernel_launch: launch failed: %s (grid %d)\n", hipGetErrorName(e), grid);
#endif
}
```

```cpp
#include <hip/hip_runtime.h>
#include <hip/hip_bf16.h>
#include <cstdio>
#include <cstdint>
#include <cmath>
namespace pg8 {
#define PG8_LAS __attribute__((address_space(3)))
typedef unsigned short bf16_t;
typedef short bf16x8 __attribute__((ext_vector_type(8)));
typedef float f32x4 __attribute__((ext_vector_type(4)));
typedef unsigned u32x4 __attribute__((ext_vector_type(4)));
constexpr int BM = 256, BK = 64, HALF = 128, HTB = HALF * BK * 2  , STAGE_BYTES = 8 * HTB, NXCD = 8, WGM = 8;

__host__ __device__ __forceinline__ int lds_byte(int r, int c) { const int st = (r >> 4) * 2 + (c >> 5), rr = r & 15, cc = c & 31, ob = rr * 64 + cc * 2; return st * 1024 + (ob ^ (((ob >> 9) & 1) << 5)); }
__host__ __device__ __forceinline__ void stage_rc(int b, int& R, int& C) { const int st = b / 1024, sb = b % 1024, swz = sb ^ (((sb >> 9) & 1) << 5); R = (st >> 1) * 16 + swz / 64; C = (st & 1) * 32 + (swz % 64) / 2; }
__host__ __device__ __forceinline__ int perm32(int rho) { const int n = rho >> 4, i = rho & 15; return 8 * (i >> 2) + 4 * n + (i & 3); }

struct Unit { int pm, pn, bn, nv, e, mt; };
struct Gemm { const bf16_t* A; const bf16_t* Bt; int K; };

struct StaticOrder {
    int nM, nN, nwg, G, c;
    __device__ void init(int M, int N, int G_, int c_) { nM = M / BM; nN = N / BM; nwg = nM * nN; G = G_; c = c_; }
    __device__ __forceinline__ bool next(int i, Unit& u) const {
        const long L = (long)i * G + c; if (L >= nwg) return false;
        int wgid = (int)L; { const int q = nwg / NXCD, r = nwg % NXCD, xcd = wgid % NXCD, off = wgid / NXCD; wgid = (xcd < r ? xcd * (q + 1) : r * (q + 1) + (xcd - r) * q) + off; }
        const int nig = WGM * nN, gid = wgid / nig, fm = gid * WGM, gsz = (nM - fm) < WGM ? (nM - fm) : WGM;
        u.pm = fm + ((wgid % nig) % gsz); u.pn = (wgid % nig) / gsz; u.bn = u.pn; u.nv = BM; u.e = 0; u.mt = 0; return true;
    }
    __device__ __forceinline__ void aoff(const Unit& u, const int (&R)[2], const int (&C)[2], int K, unsigned (&vo)[2][2]) const {
#pragma unroll
        for (int h = 0; h < 2; ++h)
#pragma unroll
            for (int i = 0; i < 2; ++i) vo[h][i] = (unsigned)((u.pm * BM + h * HALF + R[i]) * K + C[i]) * 2u;
    }
};

template <bool GATHER> struct ExpertOrder {
    int cnt[16]; int T, G, c; const int* list;
    __device__ __forceinline__ void init(const unsigned* cw, int G_, int c_, const int* list_) {
        T = 0;
#pragma unroll
        for (int e = 0; e < 16; ++e) { cnt[e] = (int)__builtin_amdgcn_readfirstlane(__hip_atomic_load(cw + 64 * e, __ATOMIC_RELAXED, __HIP_MEMORY_SCOPE_AGENT)); if (cnt[e] > 16384) cnt[e] = 16384; T += (cnt[e] + 255) >> 8; }
        G = G_; c = c_; list = list_;
    }
    __device__ __forceinline__ bool next(int i, Unit& u) const {
        const int L = i * G + c; if (L >= 4 * T) return false;
        const int rt = L >> 2; int acc = 0; u.e = 0; u.mt = 0; u.nv = 0;
#pragma unroll
        for (int e = 0; e < 16; ++e) { const int te = (cnt[e] + 255) >> 8; if (rt >= acc && rt < acc + te) { u.e = e; u.mt = rt - acc; const int left = cnt[e] - u.mt * 256; u.nv = left < 256 ? left : 256; } acc += te; }
        u.pm = rt; u.pn = L & 3; u.bn = u.e * 4 + u.pn; return true;
    }
    __device__ __forceinline__ void aoff(const Unit& u, const int (&R)[2], const int (&C)[2], int K, unsigned (&vo)[2][2]) const {
#pragma unroll
        for (int h = 0; h < 2; ++h)
#pragma unroll
            for (int i = 0; i < 2; ++i) {
                int row;
                if constexpr (GATHER) { const int rt = h * HALF + R[i]; row = 0; if (rt < u.nv) row = list[u.e * 16384 + u.mt * 256 + rt]; row &= 16383; }
                else row = u.pm * BM + h * HALF + R[i];
                vo[h][i] = (unsigned)(row * K + C[i]) * 2u;
            }
    }
};

__device__ __forceinline__ unsigned cvt_pk_bf16(float lo, float hi) { unsigned r; asm volatile("v_cvt_pk_bf16_f32 %0, %1, %2" : "=v"(r) : "v"(lo), "v"(hi)); return r; }

template <class Epi, class Sched, bool ALIGN_EPI>
__device__ __forceinline__ void gemm_phase(PG8_LAS unsigned char* lds, const Gemm g, const Sched& S, const Epi& E) {
    int tid_ = threadIdx.x; asm volatile("" : "+v"(tid_));
    const int tid = tid_, wid = __builtin_amdgcn_readfirstlane(tid >> 6), lane = tid & 63, wr = wid >> 2, wc = wid & 3, fr = lane & 15, fq = lane >> 4;
    const int K = g.K, nt = K / BK;
    int Rr[2], Cc[2]; unsigned voffB[2];
#pragma unroll
    for (int i = 0; i < 2; ++i) { int R, C; stage_rc(tid * 16 + i * 8192, R, C); Rr[i] = R; Cc[i] = C; const int Rb = (R & ~31) + perm32(R & 31); voffB[i] = (unsigned)(Rb * K + C) * 2u; }
    const unsigned kstep = (unsigned)(BK * 2);
    const size_t hstep = (size_t)HALF * K * 2;
    const size_t tstep = 2 * hstep;
    const unsigned ldsw = (unsigned)wid * 1024u;
    const int aoff = lds_byte(wr * 64 + fr, fq * 8), boff = lds_byte(wc * 32 + fr, fq * 8);
    const char* const Abase = (const char*)g.A;
#define PG8_SA(b, h) (((b) * 2 + (h)) * HTB)
#define PG8_SB(b, h) ((4 + (b) * 2 + (h)) * HTB)
#define PG8_STAGE(bufoff, gbase, voff) do { _Pragma("unroll") for (int _i = 0; _i < 2; ++_i) \
        __builtin_amdgcn_global_load_lds((const unsigned*)((const char*)(gbase) + (voff)[_i]), (PG8_LAS unsigned*)(lds + (bufoff) + ldsw + _i * 8192), 16, 0, 0); } while (0)
#define PG8_LDA(dst, b, h) do { _Pragma("unroll") for (int m = 0; m < 4; ++m) _Pragma("unroll") for (int k = 0; k < 2; ++k) dst[m][k] = *(const PG8_LAS bf16x8*)(lds + PG8_SA(b, h) + aoff + m * 2048 + k * 1024); } while (0)
#define PG8_LDB(dst, b, h) do { _Pragma("unroll") for (int n = 0; n < 2; ++n) _Pragma("unroll") for (int k = 0; k < 2; ++k) dst[n][k] = *(const PG8_LAS bf16x8*)(lds + PG8_SB(b, h) + boff + n * 2048 + k * 1024); } while (0)
#define PG8_MMA(ai, bj, At, Bt) do { __builtin_amdgcn_s_setprio(1); _Pragma("unroll") for (int m = 0; m < 4; ++m) _Pragma("unroll") for (int n = 0; n < 2; ++n) _Pragma("unroll") for (int k = 0; k < 2; ++k) \
        acc[ai][bj][m][n] = __builtin_amdgcn_mfma_f32_16x16x32_bf16(Bt[n][k], At[m][k], acc[ai][bj][m][n], 0, 0, 0); __builtin_amdgcn_s_setprio(0); } while (0)
#define PG8_WAIT_V(n) asm volatile("s_waitcnt vmcnt(" #n ")" ::: "memory")
#define PG8_WAIT_L(n) asm volatile("s_waitcnt lgkmcnt(" #n ")" ::: "memory")
#define PG8_BAR __builtin_amdgcn_s_barrier()
#define PG8_SCHED __builtin_amdgcn_sched_barrier(0)
    Unit cur, nxt; int ui = 0;
    if (!S.next(0, cur)) return;
    f32x4 acc[2][2][4][2];
#pragma unroll
    for (int a = 0; a < 2; ++a)
#pragma unroll
        for (int b = 0; b < 2; ++b)
#pragma unroll
            for (int m = 0; m < 4; ++m)
#pragma unroll
                for (int n = 0; n < 2; ++n) acc[a][b][m][n] = (f32x4){0.f, 0.f, 0.f, 0.f};
    bf16x8 At[4][2], B0[2][2], B1[2][2];
    unsigned vAc[2][2], vAn[2][2];
    S.aoff(cur, Rr, Cc, K, vAc);
    const char* cB = (const char*)g.Bt + (size_t)cur.bn * tstep;
    PG8_STAGE(PG8_SB(0, 0), cB, voffB); PG8_STAGE(PG8_SB(0, 1), cB + hstep, voffB); PG8_STAGE(PG8_SA(0, 0), Abase, vAc[0]); PG8_STAGE(PG8_SA(0, 1), Abase, vAc[1]);
    if (wr == 1) PG8_BAR;
    PG8_WAIT_V(2); PG8_BAR;
    PG8_STAGE(PG8_SB(1, 0), cB + kstep, voffB); PG8_STAGE(PG8_SA(1, 0), Abase + kstep, vAc[0]); PG8_STAGE(PG8_SB(1, 1), cB + hstep + kstep, voffB);
    PG8_WAIT_V(6); PG8_BAR;
    for (;;) {
        const bool has_next = S.next(ui + 1, nxt);
        if (has_next) S.aoff(nxt, Rr, Cc, K, vAn);
        else {
#pragma unroll
            for (int h = 0; h < 2; ++h)
#pragma unroll
                for (int i = 0; i < 2; ++i) vAn[h][i] = vAc[h][i];
        }
        const char* nB = has_next ? (const char*)g.Bt + (size_t)nxt.bn * tstep : cB;
        for (int t = 0; t < nt; t += 2) {
            const bool last = (t == nt - 2);
            const char* a1 = Abase + (size_t)(t + 1) * kstep;
            const char* a2 = last ? Abase : Abase + (size_t)(t + 2) * kstep; const char* b2 = last ? nB : cB + (size_t)(t + 2) * kstep;
            const char* a3 = a2 + kstep; const char* b3 = b2 + kstep;
            unsigned v2[2][2];
#pragma unroll
            for (int h = 0; h < 2; ++h)
#pragma unroll
                for (int i = 0; i < 2; ++i) v2[h][i] = last ? vAn[h][i] : vAc[h][i];
            PG8_LDB(B0, 0, 0); PG8_LDB(B1, 0, 1); PG8_SCHED; PG8_LDA(At, 0, 0); PG8_STAGE(PG8_SA(1, 1), a1, vAc[1]);
            PG8_WAIT_V(8); PG8_WAIT_L(0); PG8_BAR; PG8_MMA(0, 0, At, B0); PG8_MMA(0, 1, At, B1); PG8_BAR; PG8_SCHED;
            PG8_LDA(At, 0, 1); PG8_STAGE(PG8_SB(0, 0), b2, voffB); PG8_STAGE(PG8_SB(0, 1), b2 + hstep, voffB); PG8_STAGE(PG8_SA(0, 0), a2, v2[0]);
            PG8_WAIT_V(8); PG8_WAIT_L(0); PG8_BAR; PG8_MMA(1, 0, At, B0); PG8_MMA(1, 1, At, B1); PG8_BAR; PG8_SCHED;
            PG8_LDB(B0, 1, 0); PG8_LDB(B1, 1, 1); PG8_SCHED; PG8_LDA(At, 1, 0); PG8_STAGE(PG8_SA(0, 1), a2, v2[1]);
            PG8_WAIT_V(8); PG8_WAIT_L(0); PG8_BAR; PG8_MMA(0, 0, At, B0); PG8_MMA(0, 1, At, B1); PG8_BAR; PG8_SCHED;
            PG8_LDA(At, 1, 1); PG8_STAGE(PG8_SB(1, 0), b3, voffB); PG8_STAGE(PG8_SB(1, 1), b3 + hstep, voffB); PG8_STAGE(PG8_SA(1, 0), a3, v2[0]);
            PG8_WAIT_V(8); PG8_WAIT_L(0); PG8_BAR; PG8_MMA(1, 0, At, B0); PG8_MMA(1, 1, At, B1); PG8_BAR; PG8_SCHED;
        }
        if constexpr (ALIGN_EPI) { if (wr == 0) PG8_BAR; }
        E(acc, cur, wr, wc, fr, fq);
        if (!has_next) break;
#pragma unroll
        for (int a = 0; a < 2; ++a)
#pragma unroll
            for (int b = 0; b < 2; ++b)
#pragma unroll
                for (int m = 0; m < 4; ++m)
#pragma unroll
                    for (int n = 0; n < 2; ++n) acc[a][b][m][n] = (f32x4){0.f, 0.f, 0.f, 0.f};
        cur = nxt; cB = nB; ++ui;
#pragma unroll
        for (int h = 0; h < 2; ++h)
#pragma unroll
            for (int i = 0; i < 2; ++i) vAc[h][i] = vAn[h][i];
        if constexpr (ALIGN_EPI) { if (wr == 1) PG8_BAR; }
    }
    PG8_WAIT_V(0);
    if constexpr (!ALIGN_EPI) { if (wr == 0) PG8_BAR; }
    PG8_BAR;
#undef PG8_SA
#undef PG8_SB
#undef PG8_STAGE
#undef PG8_LDA
#undef PG8_LDB
#undef PG8_MMA
#undef PG8_WAIT_V
#undef PG8_WAIT_L
#undef PG8_BAR
#undef PG8_SCHED
}
}
namespace epi {
using pg8::f32x4; using pg8::u32x4; using pg8::Unit; using pg8::bf16_t; using pg8::cvt_pk_bf16;
constexpr int BM = 256, HALF = 128;
__device__ __forceinline__ u32x4 pack8(const f32x4 a, const f32x4 b) { u32x4 w; w.x = cvt_pk_bf16(a[0], a[1]); w.y = cvt_pk_bf16(a[2], a[3]); w.z = cvt_pk_bf16(b[0], b[1]); w.w = cvt_pk_bf16(b[2], b[3]); return w; }

struct EpiProj {
    bf16_t* O; size_t stride; const float* rope; float c2;
    __device__ __forceinline__ void operator()(const f32x4 (&acc)[2][2][4][2], const Unit& u, int wr, int wc, int fr, int fq) const {
        const int kind = u.pn >> 1, hf = u.pn & 1;
        bf16_t* base = O + (size_t)kind * stride;
        const float sc = (kind == 0 || kind == 3) ? c2 : 1.f;
        const int row0 = u.pm * BM + wr * 64 + fr;
        if (kind < 2) {
#pragma unroll
            for (int ai = 0; ai < 2; ++ai)
#pragma unroll
                for (int m = 0; m < 4; ++m) {
                    const int row = row0 + ai * HALF + m * 16; const int pos = row & 4095;
                    const float* rp = rope + pos * 64 + 8 * fq;
                    const f32x4 c0 = *(const f32x4*)(rp), c1 = *(const f32x4*)(rp + 4), s0 = *(const f32x4*)(rp + 32), s1 = *(const f32x4*)(rp + 36);
                    const f32x4 x10 = acc[ai][0][m][0], x11 = acc[ai][0][m][1], x20 = acc[ai][1][m][0], x21 = acc[ai][1][m][1];
                    const f32x4 o10 = (x10 * c0 - x20 * s0) * sc, o11 = (x11 * c1 - x21 * s1) * sc;
                    const f32x4 o20 = (x20 * c0 + x10 * s0) * sc, o21 = (x21 * c1 + x11 * s1) * sc;
                    bf16_t* rowp = base + (size_t)row * 512 + hf * 256 + wc * 64 + 8 * fq;
                    *(u32x4*)(rowp) = pack8(o10, o11);
                    *(u32x4*)(rowp + 32) = pack8(o20, o21);
                }
        } else {
#pragma unroll
            for (int ai = 0; ai < 2; ++ai)
#pragma unroll
                for (int m = 0; m < 4; ++m) {
                    bf16_t* rowp = base + (size_t)(row0 + ai * HALF + m * 16) * 512 + hf * 256 + wc * 32 + 8 * fq;
#pragma unroll
                    for (int bj = 0; bj < 2; ++bj) *(u32x4*)(rowp + bj * HALF) = pack8(acc[ai][bj][m][0] * sc, acc[ai][bj][m][1] * sc);
                }
        }
    }
};

struct EpiRes {
    const float* X; bf16_t* O;
    __device__ __forceinline__ void operator()(const f32x4 (&acc)[2][2][4][2], const Unit& u, int wr, int wc, int fr, int fq) const {
        const int row0 = u.pm * BM + wr * 64 + fr, col0 = u.pn * BM + wc * 32 + 8 * fq;
#pragma unroll
        for (int ai = 0; ai < 2; ++ai)
#pragma unroll
            for (int m = 0; m < 4; ++m) {
                const size_t off = (size_t)(row0 + ai * HALF + m * 16) * 1024 + col0;
#pragma unroll
                for (int bj = 0; bj < 2; ++bj) {
                    const f32x4 xa = *(const f32x4*)(X + off + bj * HALF), xb = *(const f32x4*)(X + off + bj * HALF + 4);
                    *(u32x4*)(O + off + bj * HALF) = pack8(acc[ai][bj][m][0] + xa, acc[ai][bj][m][1] + xb);
                }
                if (m & 1) asm volatile("" ::: "memory");
            }
    }
};

struct EpiSwiglu {
    bf16_t* ACT; const int* list; const float* r2;
    __device__ __forceinline__ void operator()(const f32x4 (&acc)[2][2][4][2], const Unit& u, int wr, int wc, int fr, int fq) const {
        const int rt0 = wr * 64 + fr;
#pragma unroll
        for (int ai = 0; ai < 2; ++ai)
#pragma unroll
            for (int m = 0; m < 4; ++m) {
                const int rt = rt0 + ai * HALF + m * 16;
                int tok = 0; if (rt < u.nv) tok = list[u.e * 16384 + u.mt * 256 + rt]; tok &= 16383;
                const float r = r2[tok];
                f32x4 a[2];
#pragma unroll
                for (int n = 0; n < 2; ++n) {
                    const f32x4 hg = acc[ai][0][m][n] * r, hu = acc[ai][1][m][n] * r;
#pragma unroll
                    for (int i = 0; i < 4; ++i) { const float e = __builtin_amdgcn_exp2f(hg[i] * -1.4426950408889634f); a[n][i] = hg[i] * __builtin_amdgcn_rcpf(1.0f + e) * hu[i]; }
                }
                *(u32x4*)(ACT + (size_t)(u.pm * BM + rt) * 512 + u.pn * 128 + wc * 32 + 8 * fq) = pack8(a[0], a[1]);
            }
    }
};

struct EpiY {
    bf16_t* Y;
    __device__ __forceinline__ void operator()(const f32x4 (&acc)[2][2][4][2], const Unit& u, int wr, int wc, int fr, int fq) const {
        const int row0 = u.pm * BM + wr * 64 + fr, col0 = u.pn * BM + wc * 32 + 8 * fq;
#pragma unroll
        for (int ai = 0; ai < 2; ++ai)
#pragma unroll
            for (int m = 0; m < 4; ++m) {
                bf16_t* rowp = Y + (size_t)(row0 + ai * HALF + m * 16) * 1024 + col0;
#pragma unroll
                for (int bj = 0; bj < 2; ++bj) *(u32x4*)(rowp + bj * HALF) = pack8(acc[ai][bj][m][0], acc[ai][bj][m][1]);
            }
    }
};
}
namespace attn_body {
using bf16=__hip_bfloat16;
using bf16x8=__attribute__((ext_vector_type(8)))short;
using s16x4=__attribute__((ext_vector_type(4)))short;
using f32x16=__attribute__((ext_vector_type(16)))float;
using f32x4=__attribute__((ext_vector_type(4)))float;
using u32x4=__attribute__((ext_vector_type(4)))unsigned;
constexpr int SEQ=4096,D=64,DMI=512;
constexpr int NW=8,QBLK=32,QB=QBLK*NW,KVBLK=64,NQB=SEQ/QB;
__device__ __forceinline__ int crow(int r,int hi){return (r&3)+8*(r>>2)+4*hi;}
#define SBAR() __builtin_amdgcn_sched_barrier(0)
__device__ __forceinline__ void cmask(f32x16&p0,f32x16&p1,int jb,int qrel,int hi){
  const float NEG=-INFINITY; int kb=64*jb+4*hi;
  #pragma unroll
  for(int r=0;r<16;++r){int kv=kb+(r&3)+8*(r>>2); if(kv>qrel)p0[r]=NEG; if(kv+32>qrel)p1[r]=NEG;}
}
__device__ __forceinline__ void kmask(f32x16&p0,f32x16&p1,int jb,int wid){
  const float NEG=-INFINITY;
  if(jb>(wid>>1)){
    #pragma unroll
    for(int r=0;r<16;++r){p0[r]=NEG;p1[r]=NEG;}
  }
}

constexpr int NSLOT=3, SLOTB=8192;
constexpr int LDS_K=0, LDS_V=NSLOT*SLOTB, LDS_WS=2*NSLOT*SLOTB, LDS_OST=LDS_WS+NW*64*4, LDS_GL=LDS_OST+NW*4096, LDS_BYTES=LDS_GL+SEQ*4;
constexpr float C2=0.125f*1.4426950408889634f;
__device__ __forceinline__ void glds16(const void*gsrc,unsigned lds_dst){unsigned keep;
  asm volatile("s_mov_b32 %0, m0\n\ts_mov_b32 m0, %2\n\ts_nop 0\n\tglobal_load_lds_dwordx4 %1, off\n\ts_mov_b32 m0, %0":"=&s"(keep):"v"(gsrc),"s"(lds_dst):"memory");}
__device__ __forceinline__ float max3f(float a,float b,float c){float r;asm("v_max3_f32 %0, %1, %2, %3":"=v"(r):"v"(a),"v"(b),"v"(c));return r;}
__device__ __forceinline__ float max2f(float a,float b){float r;asm("v_max_f32_e32 %0, %1, %2":"=v"(r):"v"(a),"v"(b));return r;}
__device__ __forceinline__ float fsub_s(float a,float b){float r;asm("v_sub_f32_e32 %0, %1, %2":"=v"(r):"v"(a),"v"(b));return r;}
typedef float f32x2_t __attribute__((ext_vector_type(2))); typedef __bf16 bf16x2_t __attribute__((ext_vector_type(2)));
__device__ __forceinline__ unsigned cvtpk_s(float lo,float hi){f32x2_t v={lo,hi};bf16x2_t b=__builtin_convertvector(v,bf16x2_t);return __builtin_bit_cast(unsigned,b);}
__device__ __forceinline__ float bf_lo(unsigned w){return __uint_as_float(w<<16);} __device__ __forceinline__ float bf_hi(unsigned w){return __uint_as_float(w&0xffff0000u);}
#define WAIT_BAR(N) asm volatile("s_waitcnt vmcnt(" #N ") lgkmcnt(0)\n\ts_barrier":::"memory")

__device__ __forceinline__ void qkt(f32x16&p0,f32x16&p1,const char*Kslot,const bf16x8*qr,const f32x16&c0,const f32x16&c1,int r32,int hi){
  const char*kb=Kslot+hi*1024+r32*16;
  #pragma unroll
  for(int d0=0;d0<4;++d0){
    const bf16x8 b0=*reinterpret_cast<const bf16x8*>(kb+d0*2048);
    const bf16x8 b1=*reinterpret_cast<const bf16x8*>(kb+d0*2048+512);
    if(d0==0){p0=__builtin_amdgcn_mfma_f32_32x32x16_bf16(b0,qr[0],c0,0,0,0);p1=__builtin_amdgcn_mfma_f32_32x32x16_bf16(b1,qr[0],c1,0,0,0);}
    else{p0=__builtin_amdgcn_mfma_f32_32x32x16_bf16(b0,qr[d0],p0,0,0,0);p1=__builtin_amdgcn_mfma_f32_32x32x16_bf16(b1,qr[d0],p1,0,0,0);}}
}
typedef __attribute__((address_space(3))) const char* lds_cptr;
typedef short v4i16_t __attribute__((ext_vector_type(4)));
__device__ __forceinline__ void kload8(bf16x8*kf,lds_cptr kp){
  kf[0]=*(const __attribute__((address_space(3))) bf16x8*)(kp);      kf[1]=*(const __attribute__((address_space(3))) bf16x8*)(kp+512);
  kf[2]=*(const __attribute__((address_space(3))) bf16x8*)(kp+2048); kf[3]=*(const __attribute__((address_space(3))) bf16x8*)(kp+2560);
  kf[4]=*(const __attribute__((address_space(3))) bf16x8*)(kp+4096); kf[5]=*(const __attribute__((address_space(3))) bf16x8*)(kp+4608);
  kf[6]=*(const __attribute__((address_space(3))) bf16x8*)(kp+6144); kf[7]=*(const __attribute__((address_space(3))) bf16x8*)(kp+6656);
}
__device__ __forceinline__ void kload2(bf16x8*kf,lds_cptr kp,int j){ kf[2*j]=*(const __attribute__((address_space(3))) bf16x8*)(kp+j*2048); kf[2*j+1]=*(const __attribute__((address_space(3))) bf16x8*)(kp+j*2048+512); }
__device__ __forceinline__ s16x4 vtr(lds_cptr p){ return __builtin_bit_cast(s16x4,__builtin_amdgcn_ds_read_tr16_b64_v4i16((__attribute__((address_space(3))) v4i16_t*)p)); }
typedef __attribute__((address_space(3))) const float* lds_fptr;
__device__ __forceinline__ void bias_tuples(f32x16&c0,f32x16&c1,lds_fptr glt,int hi,float nmh){
  #pragma unroll
  for(int g=0;g<4;++g){
    const f32x4 a=*(const __attribute__((address_space(3))) f32x4*)(glt+8*g+4*hi);
    const f32x4 b=*(const __attribute__((address_space(3))) f32x4*)(glt+32+8*g+4*hi);
    #pragma unroll
    for(int i=0;i<4;++i){c0[4*g+i]=a[i]+nmh;c1[4*g+i]=b[i]+nmh;}
  }
}
__device__ __forceinline__ float rowmax(const f32x16&p0,const f32x16&p1){
  float a=max3f(p0[0],p0[1],p1[0]),b=max3f(p0[2],p0[3],p1[1]);a=max3f(a,p1[2],p1[3]);
  #pragma unroll
  for(int r=4;r<16;r+=4){a=max3f(a,p0[r],p0[r+1]);b=max3f(b,p0[r+2],p0[r+3]);a=max3f(a,p1[r],p1[r+1]);b=max3f(b,p1[r+2],p1[r+3]);}
  const float m=max2f(a,b);
  auto rr=__builtin_amdgcn_permlane32_swap(__float_as_uint(m),__float_as_uint(m),false,false);
  return max2f(__uint_as_float(rr[0]),__uint_as_float(rr[1]));
}
__device__ __forceinline__ void pv(f32x16*o,int vb,bf16x8 pa0,bf16x8 pa1,bf16x8 pa2,bf16x8 pa3){
  #pragma unroll
  for(int d0=0;d0<2;++d0){s16x4 lo[4],hi[4];
    #pragma unroll
    for(int ks=0;ks<4;++ks){
      asm volatile("ds_read_b64_tr_b16 %0,%1 offset:%c2":"=&v"(lo[ks]):"v"(vb),"i"(d0*4096+ks*1024):"memory");
      asm volatile("ds_read_b64_tr_b16 %0,%1 offset:%c2":"=&v"(hi[ks]):"v"(vb),"i"(d0*4096+ks*1024+512):"memory");}
    asm volatile("s_waitcnt lgkmcnt(0)":::"memory");SBAR();
    #define PK(k) (bf16x8){lo[k][0],lo[k][1],lo[k][2],lo[k][3],hi[k][0],hi[k][1],hi[k][2],hi[k][3]}
    o[d0]=__builtin_amdgcn_mfma_f32_32x32x16_bf16(pa0,PK(0),o[d0],0,0,0);
    o[d0]=__builtin_amdgcn_mfma_f32_32x32x16_bf16(pa1,PK(1),o[d0],0,0,0);
    o[d0]=__builtin_amdgcn_mfma_f32_32x32x16_bf16(pa2,PK(2),o[d0],0,0,0);
    o[d0]=__builtin_amdgcn_mfma_f32_32x32x16_bf16(pa3,PK(3),o[d0],0,0,0);
    #undef PK
  }
}

template<int MODE,int THRL> __device__ __forceinline__ void attn_unit(long rowbase,int qb,const bf16*Q,const bf16*__restrict__ K,const bf16*__restrict__ V,bf16*O,int opitch,const float*glp,float lam,float*ssp,char*shm){
  int tid_=threadIdx.x; asm volatile("":"+v"(tid_));
  const int tid=tid_,lane=tid&63,r32=lane&31,hi=lane>>5; const int wid=__builtin_amdgcn_readfirstlane(tid>>6);
  const int q0=qb*QB;
  const bf16*Qw=Q+(rowbase+q0+wid*QBLK)*DMI;
  const bf16*Kh=K+rowbase*DMI,*Vh=V+rowbase*DMI;
  const unsigned lds0=(unsigned)(uintptr_t)shm;
  float*wsf=(float*)(shm+LDS_WS)+wid*64;
  const int NT=(q0+QB)/KVBLK;
  const lds_cptr shm3=(lds_cptr)shm;
  const lds_fptr glt0=(lds_fptr)(shm3+LDS_GL);
  if constexpr(MODE==0){
    __attribute__((address_space(3))) f32x4* gd=(__attribute__((address_space(3))) f32x4*)(shm3+LDS_GL);
    const int n4=(q0+QB)>>2;
    for(int i=tid;i<n4;i+=NW*64){ const f32x4 v=*(const f32x4*)(glp+4*i); gd[i]=v; }
  }
  const bf16*ksrc=Kh+(long)lane*DMI+wid*8;
  const bf16*vsrc=Vh+(long)(16*(wid&3)+(lane>>2))*DMI+(wid>>2)*32+(lane&3)*8;
  const unsigned kdst=lds0+LDS_K+wid*1024, vdst=lds0+LDS_V+wid*1024;
  #define DMA_K(t,slot) glds16(ksrc+(long)(t)*KVBLK*DMI,(unsigned)__builtin_amdgcn_readfirstlane(kdst+(slot)))
  #define DMA_V(t,slot) glds16(vsrc+(long)(t)*KVBLK*DMI,(unsigned)__builtin_amdgcn_readfirstlane(vdst+(slot)))
  const int vb0=(int)(lds0+LDS_V)+((lane>>4)&1)*32+(lane&3)*8+(4*hi+((lane&15)>>2))*64;
  const char*Kbase=shm+LDS_K; bf16x8 kf[8];
  const lds_cptr kp0=shm3+LDS_K+hi*1024+r32*16; const lds_cptr vp0=shm3+LDS_V+((lane>>4)&1)*32+(lane&3)*8+(4*hi+((lane&15)>>2))*64;
  DMA_K(0,0);DMA_V(0,0);DMA_K(1,SLOTB);
  bf16x8 qr[4];
  #pragma unroll
  for(int d0=0;d0<4;++d0)qr[d0]=*reinterpret_cast<const bf16x8*>(&Qw[(long)r32*DMI+d0*16+hi*8]);
  float mhat=0.f,l_reg=0.f;f32x16 o[2];o[0]=f32x16{};o[1]=f32x16{};f32x16 negm=f32x16{};asm volatile("":"+v"(negm));
  float nmh=0.f;
  const int qrel=wid*QBLK+r32;
  #define CMASK(P0,P1,t) do{int jb_=(t)-(NT-4); if(jb_>=0){ if constexpr(MODE==0)cmask(P0,P1,jb_,qrel,hi); else kmask(P0,P1,jb_,wid);} }while(0)
  bool resc=false;
  #define SETREF() do{ if constexpr(MODE==0){ nmh=-mhat; } else { _Pragma("unroll") for(int r=0;r<16;++r)negm[r]=-mhat; asm volatile("":"+v"(negm)); } }while(0)
  #define START(P0,P1) do{ const float rm=rowmax(P0,P1); resc=false; \
    { const float dl=rm; mhat=mhat+dl; \
      _Pragma("unroll") for(int r=0;r<16;++r){P0[r]=fsub_s(P0[r],dl);P1[r]=fsub_s(P1[r],dl);} \
      SETREF(); } \
    _Pragma("unroll") for(int r=0;r<16;++r)P0[r]=__builtin_amdgcn_exp2f(P0[r]); }while(0)
  #define RESC() do{ if(resc){ asm volatile("s_waitcnt lgkmcnt(0)":::"memory"); \
      _Pragma("unroll") for(int d_=0;d_<2;++d_) _Pragma("unroll") for(int r=0;r<16;++r)o[d_][r]*=wsf[crow(r,hi)]; } }while(0)
  f32x16 pA0,pA1,pB0,pB1;
  int sl_prev=0,sl_cur=0,sl_next=SLOTB;
  #define ROT() do{sl_prev=sl_cur;sl_cur=sl_next;sl_next=(sl_next==(NSLOT-1)*SLOTB)?0:sl_next+SLOTB;}while(0)
  DMA_K(2,2*SLOTB);
  WAIT_BAR(3);
  if constexpr(MODE==0){ f32x16 c0,c1; bias_tuples(c0,c1,glt0,hi,0.f); qkt(pA0,pA1,Kbase,qr,c0,c1,r32,hi); }
  else qkt(pA0,pA1,Kbase,qr,negm,negm,r32,hi);
  asm volatile("s_nop 15\n\ts_nop 7":"+v"(pA0),"+v"(pA1));CMASK(pA0,pA1,0);
  START(pA0,pA1);
  _Pragma("unroll") for(int r=0;r<16;++r)pA1[r]=__builtin_amdgcn_exp2f(pA1[r]);
  WAIT_BAR(0);
  DMA_K(3,0);DMA_V(1,SLOTB);
  ROT();
  kload8(kf,kp0+sl_cur);
  WAIT_BAR(2);
  s16x4 vlo[8],vhi[8]; u32x4 pw0,pw1,pw2,pw3;
  #define PKW(P,B) cvtpk_s(P[B],P[B+1])
  #define PAF(k) __builtin_bit_cast(bf16x8,pw##k)
  #define VFR(i) (bf16x8){vlo[i][0],vlo[i][1],vlo[i][2],vlo[i][3],vhi[i][0],vhi[i][1],vhi[i][2],vhi[i][3]}
  #define PIN(x) asm volatile("":"+v"(x))
  #define MX3(a,b,c) __builtin_fmaxf(__builtin_fmaxf((a),(b)),(c))
  #define GAPA(MF,A0,A1,A2,A3,W0,W1,PW) do{ MF; sacc+=A0; sacc+=A1; sacc+=A2; sacc+=A3; PIN(sacc); W0; W1; PIN(PW); SBAR(); }while(0)
  #define EX(v) __builtin_amdgcn_exp2f(v)
  #define GAPB(MF,X,B) do{ MF; X[B]=EX(X[B]); X[B+1]=EX(X[B+1]); X[B+2]=EX(X[B+2]); X[B+3]=EX(X[B+3]); PIN(X); SBAR(); }while(0)
  #define VRD(i) do{ vlo[i]=vtr(vp_+(((i)>>2)*4096+((i)&3)*1024)); vhi[i]=vtr(vp_+(((i)>>2)*4096+((i)&3)*1024+512)); }while(0)
  #define KRD(G,j) do{ if(G){ kload2(kf,kp0+sl_next,j); SBAR(); } }while(0)
  #define STEP(C0,C1,P0,P1,t,GK,GV,GL) do{ SBAR(); \
    f32x16 ci0_,ci1_; if constexpr(MODE==0){ bias_tuples(ci0_,ci1_,glt0+64*(t),hi,nmh); } else { ci0_=negm; ci1_=negm; } \
    const lds_cptr vp_=vp0+sl_prev; \
    VRD(0); SBAR(); float sacc=(P0[0]+P0[1]); \
    GAPA(C0=__builtin_amdgcn_mfma_f32_32x32x16_bf16(kf[0],qr[0],ci0_,0,0,0), P0[2],P0[3],P0[4],P0[5],     pw0[0]=PKW(P0,0), pw0[1]=PKW(P0,2), pw0); \
    VRD(4); SBAR(); GAPA(C1=__builtin_amdgcn_mfma_f32_32x32x16_bf16(kf[1],qr[0],ci1_,0,0,0), P0[6],P0[7],P0[8],P0[9],     pw0[2]=PKW(P0,4), pw0[3]=PKW(P0,6), pw0); \
    VRD(1); SBAR(); GAPA(C0=__builtin_amdgcn_mfma_f32_32x32x16_bf16(kf[2],qr[1],C0,0,0,0),   P0[10],P0[11],P0[12],P0[13], pw1[0]=PKW(P0,8), pw1[1]=PKW(P0,10), pw1); \
    VRD(5); SBAR(); GAPA(C1=__builtin_amdgcn_mfma_f32_32x32x16_bf16(kf[3],qr[1],C1,0,0,0),   P0[14],P0[15],P1[0],P1[1],   pw1[2]=PKW(P0,12),pw1[3]=PKW(P0,14), pw1); \
    VRD(2); SBAR(); GAPA(C0=__builtin_amdgcn_mfma_f32_32x32x16_bf16(kf[4],qr[2],C0,0,0,0),   P1[2],P1[3],P1[4],P1[5],     pw2[0]=PKW(P1,0), pw2[1]=PKW(P1,2), pw2); \
    VRD(6); SBAR(); GAPA(C1=__builtin_amdgcn_mfma_f32_32x32x16_bf16(kf[5],qr[2],C1,0,0,0),   P1[6],P1[7],P1[8],P1[9],     pw2[2]=PKW(P1,4), pw2[3]=PKW(P1,6), pw2); \
    VRD(3); SBAR(); GAPA(C0=__builtin_amdgcn_mfma_f32_32x32x16_bf16(kf[6],qr[3],C0,0,0,0),   P1[10],P1[11],P1[12],P1[13], pw3[0]=PKW(P1,8), pw3[1]=PKW(P1,10), pw3); \
    VRD(7); SBAR(); GAPA(C1=__builtin_amdgcn_mfma_f32_32x32x16_bf16(kf[7],qr[3],C1,0,0,0),   P1[14],P1[15],0.f,0.f,       pw3[2]=PKW(P1,12),pw3[3]=PKW(P1,14), pw3); \
    l_reg+=sacc; \
    if(GK){DMA_K((t)+3,sl_cur);} if(GV){DMA_V((t)+1,sl_next);} \
    CMASK(C0,C1,t); \
    { float a=MX3(C0[0],C0[1],C1[0]),b=MX3(C0[2],C0[3],C1[1]); a=MX3(a,C1[2],C1[3]); \
      _Pragma("unroll") for(int r=4;r<16;r+=4){a=MX3(a,C0[r],C0[r+1]);b=MX3(b,C0[r+2],C0[r+3]);a=MX3(a,C1[r],C1[r+1]);b=MX3(b,C1[r+2],C1[r+3]);} \
      float rm=__builtin_fmaxf(a,b); { auto rr=__builtin_amdgcn_permlane32_swap(__float_as_uint(rm),__float_as_uint(rm),false,false); rm=__builtin_fmaxf(__uint_as_float(rr[0]),__uint_as_float(rr[1])); } \
      resc=false; \
      if(__builtin_expect(__any(rm>(float)THRL),0)){ const float dl=__builtin_fmaxf(rm,0.f); mhat+=dl; \
        _Pragma("unroll") for(int r=0;r<16;++r){C0[r]-=dl;C1[r]-=dl;} \
        SETREF(); \
        const float f=__builtin_amdgcn_exp2f(-dl); l_reg*=f; if(hi==0)wsf[r32]=f; resc=true; } } \
    SBAR(); \
    GAPB(o[0]=__builtin_amdgcn_mfma_f32_32x32x16_bf16(PAF(0),VFR(0),o[0],0,0,0), C0,0); \
    GAPB(o[1]=__builtin_amdgcn_mfma_f32_32x32x16_bf16(PAF(0),VFR(4),o[1],0,0,0), C0,4); \
    KRD(GL,0); GAPB(o[0]=__builtin_amdgcn_mfma_f32_32x32x16_bf16(PAF(1),VFR(1),o[0],0,0,0), C0,8); \
    KRD(GL,1); GAPB(o[1]=__builtin_amdgcn_mfma_f32_32x32x16_bf16(PAF(1),VFR(5),o[1],0,0,0), C0,12); \
    KRD(GL,2); GAPB(o[0]=__builtin_amdgcn_mfma_f32_32x32x16_bf16(PAF(2),VFR(2),o[0],0,0,0), C1,0); \
    KRD(GL,3); GAPB(o[1]=__builtin_amdgcn_mfma_f32_32x32x16_bf16(PAF(2),VFR(6),o[1],0,0,0), C1,4); \
    GAPB(o[0]=__builtin_amdgcn_mfma_f32_32x32x16_bf16(PAF(3),VFR(3),o[0],0,0,0), C1,8); \
    GAPB(o[1]=__builtin_amdgcn_mfma_f32_32x32x16_bf16(PAF(3),VFR(7),o[1],0,0,0), C1,12); \
    }while(0)
  int t=1;
  #undef CMASK
  #define CMASK(P0,P1,t) do{}while(0)
  for(;t+5<NT;t+=2){
    STEP(pB0,pB1,pA0,pA1,t,true,true,true);     WAIT_BAR(2); RESC(); ROT();
    STEP(pA0,pA1,pB0,pB1,t+1,true,true,true);   WAIT_BAR(2); RESC(); ROT();
  }
  #undef CMASK
  #define CMASK(P0,P1,t) do{int jb_=(t)-(NT-4); if(jb_>=0){ if constexpr(MODE==0)cmask(P0,P1,jb_,qrel,hi); else kmask(P0,P1,jb_,wid);} }while(0)
  #define ENDW(tt) do{ if((tt)+3<NT){WAIT_BAR(2);} else if((tt)+2<NT){WAIT_BAR(1);} else {WAIT_BAR(0);} }while(0)
  for(;t+1<NT;t+=2){
    STEP(pB0,pB1,pA0,pA1,t,(t+3<NT),(t+1<NT),(t+1<NT));       ENDW(t);   RESC(); ROT();
    STEP(pA0,pA1,pB0,pB1,t+1,(t+4<NT),(t+2<NT),(t+2<NT));     ENDW(t+1); RESC(); ROT();
  }
  STEP(pB0,pB1,pA0,pA1,NT-1,false,false,false); RESC();
  { float sacc=pB0[0]+pB0[1]; _Pragma("unroll") for(int r=2;r<16;++r)sacc+=pB0[r]; _Pragma("unroll") for(int r=0;r<16;++r)sacc+=pB1[r]; l_reg+=sacc;
    pw0=(u32x4){PKW(pB0,0),PKW(pB0,2),PKW(pB0,4),PKW(pB0,6)};pw1=(u32x4){PKW(pB0,8),PKW(pB0,10),PKW(pB0,12),PKW(pB0,14)};pw2=(u32x4){PKW(pB1,0),PKW(pB1,2),PKW(pB1,4),PKW(pB1,6)};pw3=(u32x4){PKW(pB1,8),PKW(pB1,10),PKW(pB1,12),PKW(pB1,14)};
    SBAR(); pv(o,vb0+sl_cur,PAF(0),PAF(1),PAF(2),PAF(3)); }
  #undef PKW
  #undef PAF
  #undef VFR
  #undef PIN
  #undef MX3
  #undef GAPA
  #undef GAPB
  #undef EX
  #undef VRD
  #undef KRD
  #undef STEP
  #undef ENDW
  {auto rr=__builtin_amdgcn_permlane32_swap(__float_as_uint(l_reg),__float_as_uint(l_reg),false,false);l_reg=__uint_as_float(rr[0])+__uint_as_float(rr[1]);}
  if(hi==0)wsf[32+r32]=l_reg;asm volatile("s_waitcnt lgkmcnt(0)":::"memory");
  float rli[16];
  #pragma unroll
  for(int r=0;r<16;++r)rli[r]=__builtin_amdgcn_rcpf(wsf[32+crow(r,hi)]);
  bf16*Ow=O+(rowbase+q0+wid*QBLK)*(long)opitch;
  { bf16*stg=(bf16*)(shm+LDS_OST)+wid*2048;
    #pragma unroll
    for(int r=0;r<16;++r){const int orow=crow(r,hi);
      #pragma unroll
      for(int d0=0;d0<2;++d0){
        float val=o[d0][r]*rli[r];
        if constexpr(MODE==2){ val=__bfloat162float(stg[orow*64+d0*32+r32])-lam*val; }
        stg[orow*64+d0*32+r32]=__float2bfloat16(val);}}
    asm volatile("s_waitcnt lgkmcnt(0)":::"memory");
    if constexpr(MODE!=1){
      #pragma unroll
      for(int i=0;i<4;++i){const int row=i*8+(lane>>3),ch=lane&7; const u32x4 v=*(const u32x4*)(stg+row*64+ch*8);
        if constexpr(MODE==2){
          float s=0.f;
          #pragma unroll
          for(int j=0;j<4;++j){const float a=bf_lo(v[j]),b=bf_hi(v[j]); s+=a*a+b*b;}
          s+=__shfl_xor(s,1); s+=__shfl_xor(s,2); s+=__shfl_xor(s,4);
          if(ch==0)ssp[(rowbase+q0+wid*QBLK+row)*8]=s;
        }
        *(u32x4*)(Ow+(long)row*opitch+ch*8)=v;} }
  }
  asm volatile("s_waitcnt lgkmcnt(0)\n\ts_barrier":::"memory");
  #undef DMA_K
  #undef DMA_V
  #undef CMASK
  #undef START
  #undef SETREF
  #undef RESC
  #undef ROT
}
#undef SBAR
#undef WAIT_BAR
}
#ifndef REPMASK
#define REPMASK 0
#endif
#define REPS(k) (((REPMASK) >> (k)) & 1 ? 2 : 1)
#ifndef AMM
#define AMM 3
#endif
#ifndef PHM
#define PHM 1023
#endif
constexpr int NWAVES = 8;
constexpr int BATCH = 4, SEQ = 4096, DM = 1024, M = BATCH * SEQ;
constexpr int DIN = 3080, NPROJ = 3072, NEXP = 16, DEXP = 512, LISTCAP = 16384;
constexpr float EPS = 1e-6f, LOG2E = 1.4426950408889634f;
constexpr float LAM_INIT = 0.2f;

constexpr size_t MiB = 1u << 20;
constexpr size_t WS_CTL = 0, CTL_ZERO_BYTES = 1 * MiB;
constexpr size_t WS_GL = 1 * MiB;
constexpr size_t WS_FLOG = WS_GL + 512 * 1024;
constexpr size_t WS_ROPE = 2 * MiB;
constexpr size_t WS_WR = 3 * MiB;
constexpr size_t WS_SS = 3 * MiB + 256 * 1024;
constexpr size_t WS_WIN = 4 * MiB, WS_WOUT = 10 * MiB, WS_WGU = 12 * MiB, WS_WD = 44 * MiB;
constexpr size_t WS_XN = 60 * MiB;
constexpr size_t WS_DD = 60 * MiB;
constexpr size_t WS_LIST = 76 * MiB;
constexpr size_t WS_TOKI = 77 * MiB;
constexpr size_t WS_TOKW = 77 * MiB + 256 * 1024;
constexpr size_t WS_R2 = 77 * MiB + 384 * 1024;
constexpr size_t WS_QKV = 92 * MiB, QKV_STRIDE = 16 * MiB;
constexpr size_t WS_ACT = 92 * MiB;
constexpr size_t WS_Y = 128 * MiB;
constexpr size_t WS_OA = 188 * MiB;
constexpr size_t WS_X1B = 220 * MiB;
constexpr size_t WS_END = 252 * MiB;
constexpr int CW_TMO = 0, CW_CODE = 1, CW_BAR = 4096, CW_CNT = 8192;
constexpr int RING_OFF = 0, RING_BYTES = 131072;
constexpr int LDSCTL_OFF = RING_BYTES, MISC_OFF = LDSCTL_OFF + 320;
constexpr int LDS_BYTES = 147456;
static_assert(MISC_OFF + 128 <= LDS_BYTES, "LDS map");
static_assert(attn_body::LDS_BYTES <= RING_BYTES, "attention scratch fits the ring region");

#define GAS __attribute__((address_space(1)))
#define LAS __attribute__((address_space(3)))
typedef unsigned short bf16;
typedef unsigned v4u __attribute__((ext_vector_type(4)));
typedef float f32x4 __attribute__((ext_vector_type(4)));
typedef GAS unsigned gu32;
#define RLX_AGENT __ATOMIC_RELAXED, __HIP_MEMORY_SCOPE_AGENT
#define LDS_WAIT() asm volatile("s_waitcnt lgkmcnt(0)" ::: "memory")
#define VM_WAIT() asm volatile("s_waitcnt vmcnt(0)" ::: "memory")
__device__ __forceinline__ unsigned f2bf(float f) { unsigned u = __builtin_bit_cast(unsigned, f); return (u + 0x7fffu + ((u >> 16) & 1u)) >> 16; }
__device__ __forceinline__ unsigned pk2(float lo, float hi) { return f2bf(lo) | (f2bf(hi) << 16); }
__device__ __forceinline__ float bflo(unsigned w) { return __uint_as_float(w << 16); }
__device__ __forceinline__ float bfhi(unsigned w) { return __uint_as_float(w & 0xffff0000u); }

#define XB_TMO      128
#define XB_XCNT(j)  (256  + 64 * (j))
#define XB_XSUB(j)  (1280 + 64 * (j))
#define XB_XGEN(j)  (2304 + 64 * (j))
#define XB_TOP      3328
#define XB_TOPGEN   3392
#define XCD_BAR_WORDS 3456
#define XB_SPIN_CAP (1u << 18)
__device__ __forceinline__ unsigned xb_ld(unsigned* p)              { return __hip_atomic_load(p, __ATOMIC_RELAXED, __HIP_MEMORY_SCOPE_AGENT); }
__device__ __forceinline__ unsigned xb_add(unsigned* p, unsigned v) { return __hip_atomic_fetch_add(p, v, __ATOMIC_RELAXED, __HIP_MEMORY_SCOPE_AGENT); }
__device__ __forceinline__ unsigned xb_xcc_id() { return (unsigned)__builtin_amdgcn_s_getreg((3 << 11) | 20) & 0xFu; }
#define XB_SPIN(cond, bar) do { unsigned _sp = 0; while (cond) { __builtin_amdgcn_s_sleep(1); \
    if ((++_sp & 255u) == 0u) { if (xb_ld(&(bar)[XB_TMO])) break; if (_sp > XB_SPIN_CAP) { atomicAdd(&(bar)[XB_TMO], 1u); break; } } } } while (0)
struct XcdBarrier { unsigned* bar; unsigned x; volatile LAS unsigned* st; };
__device__ __forceinline__ XcdBarrier xcd_barrier_post(unsigned* bar, volatile LAS unsigned* st) {
    XcdBarrier b; b.bar = bar; b.x = xb_xcc_id(); b.st = st;
    if (threadIdx.x == 0) (void)xb_add(&bar[XB_XCNT(b.x)], 1u);
    return b;
}
__device__ __forceinline__ void xcd_barrier_complete(unsigned* bar, unsigned x, unsigned& nloc, unsigned& nx) {
    const unsigned G = gridDim.x * gridDim.y * gridDim.z;
    unsigned sum, cnt, mine, sp = 0u;
    for (;;) {
        sum = 0u; cnt = 0u; mine = 0u;
#pragma unroll
        for (unsigned j = 0; j < 16; ++j) { const unsigned c = xb_ld(&bar[XB_XCNT(j)]); sum += c; cnt += (c > 0u) ? 1u : 0u; mine = (j == x) ? c : mine; }
        if (sum == G) break;
        __builtin_amdgcn_s_sleep(1);
        if ((++sp & 255u) == 0u) { if (xb_ld(&bar[XB_TMO])) break; if (sp > XB_SPIN_CAP) { atomicAdd(&bar[XB_TMO], 1u); break; } }
    }
    nloc = mine > 0u ? mine : 1u; nx = cnt > 0u ? cnt : 1u;
}
__device__ __forceinline__ void xcd_barrier(const XcdBarrier& b) {
    asm volatile("s_waitcnt vmcnt(0)" ::: "memory");
    __syncthreads();
    if (threadIdx.x == 0) {
        unsigned* bar = b.bar;
        __builtin_amdgcn_s_waitcnt(0);
        unsigned nloc = b.st[0], nx = b.st[1];
        if (nloc == 0u) { xcd_barrier_complete(bar, b.x, nloc, nx); b.st[0] = nloc; b.st[1] = nx; }
        const unsigned old = xb_add(&bar[XB_XSUB(b.x)], 1u);
        const unsigned gen = old / nloc;
        if (old + 1u == (gen + 1u) * nloc) {
            __builtin_amdgcn_fence(__ATOMIC_RELEASE, "agent");
            asm volatile("s_waitcnt vmcnt(0)" ::: "memory");
            const unsigned og = xb_add(&bar[XB_TOP], 1u);
            const unsigned tg = og / nx;
            if (og + 1u == (tg + 1u) * nx) xb_add(&bar[XB_TOPGEN], 1u);
            else XB_SPIN(xb_ld(&bar[XB_TOPGEN]) == tg, bar);
            __builtin_amdgcn_fence(__ATOMIC_ACQUIRE, "agent");
            xb_add(&bar[XB_XGEN(b.x)], 1u);
            asm volatile("s_waitcnt vmcnt(0)" ::: "memory");
        } else {
            XB_SPIN(xb_ld(&bar[XB_XGEN(b.x)]) == gen, bar);
            __builtin_amdgcn_fence(__ATOMIC_ACQUIRE, "agent");
            asm volatile("s_waitcnt vmcnt(0)" ::: "memory");
        }
    }
    __syncthreads();
}

struct Args { const float* in[19]; float* out; unsigned char* ws; };

struct Frame {
    LAS unsigned char* lds; volatile LAS unsigned* MISC; gu32* ctl;
    int tid, lane, wave, vcu, G;
};

__device__ __forceinline__ float wave_sum(float v) {
#pragma unroll
    for (int o = 1; o < 64; o <<= 1) v += __shfl_xor(v, o);
    return v;
}

template <int CTRL> __device__ __forceinline__ float dppf(float v) { return __builtin_bit_cast(float, __builtin_amdgcn_update_dpp(0, __builtin_bit_cast(int, v), CTRL, 0xf, 0xf, false)); }
__device__ __forceinline__ float wave_sum_fast(float v) {
    v += dppf<0xB1>(v); v += dppf<0x4E>(v); v += dppf<0x124>(v); v += dppf<0x128>(v);
    v += __shfl_xor(v, 16);
    auto rr = __builtin_amdgcn_permlane32_swap(__float_as_uint(v), __float_as_uint(v), false, false);
    return __uint_as_float(rr[0]) + __uint_as_float(rr[1]);
}

struct TrItem { const float* src; const float* gk; bf16* dst; int ldw, K; };
__device__ __forceinline__ TrItem tr_decode(int it, const Args& a, int lane) {
    constexpr int I_IN = 16 * 96, I_OUT = 16 * 32, I_GU = 16 * 2 * 16 * 16;
    unsigned char* ws = a.ws; TrItem t; int r = it; int n0s, k0, dn0; const float* W;
    if (r < I_IN) { const int kb = r / 96, nb = r % 96;
        if (nb < 32) { const int U = nb >> 1, hf = nb & 1; dn0 = (U >> 2) * 256 + hf * 128 + 32 * (U & 3); } else dn0 = 32 * nb;
        W = a.in[2]; t.ldw = DIN; n0s = 32 * nb; k0 = 64 * kb; t.gk = a.in[1] + k0; t.K = DM; t.dst = (bf16*)(ws + WS_WIN) + (size_t)dn0 * DM + k0; }
    else if ((r -= I_IN) < I_OUT) { const int kb = r / 32, nb = r % 32;
        W = a.in[9]; t.ldw = DM; n0s = 32 * nb; k0 = 64 * kb; t.gk = nullptr; t.K = DM; t.dst = (bf16*)(ws + WS_WOUT) + (size_t)(32 * nb) * DM + k0; }
    else if ((r -= I_OUT) < I_GU) { const int e = r / 512, q = r % 512, up = q / 256, q2 = q % 256, kb = q2 / 16, nb = q2 % 16;
        W = (up ? a.in[16] : a.in[15]) + (size_t)e * DM * DEXP; t.ldw = DEXP; n0s = 32 * nb; k0 = 64 * kb; t.gk = a.in[10] + k0; t.K = DM;
        dn0 = e * 1024 + (nb >> 2) * 256 + up * 128 + (nb & 3) * 32; t.dst = (bf16*)(ws + WS_WGU) + (size_t)dn0 * DM + k0; }
    else { r -= I_GU; const int e = r / 256, q = r % 256, kb = q / 32, nb = q % 32;
        W = a.in[17] + (size_t)e * DEXP * DM; t.ldw = DM; n0s = 32 * nb; k0 = 64 * kb; t.gk = nullptr; t.K = DEXP; t.dst = (bf16*)(ws + WS_WD) + (size_t)(e * 1024 + 32 * nb) * DEXP + k0; }
    t.src = W + (size_t)(k0 + (lane >> 5)) * t.ldw + n0s + (lane & 31);
    return t;
}
__device__ __forceinline__ unsigned cvtpk_hw(float lo, float hi) { typedef float f2_t __attribute__((ext_vector_type(2))); typedef __bf16 b2_t __attribute__((ext_vector_type(2))); f2_t v = {lo, hi}; b2_t b = __builtin_convertvector(v, b2_t); return __builtin_bit_cast(unsigned, b); }

__device__ __forceinline__ void p0_prologue(Frame& F, const Args& a) {
    unsigned char* ws = a.ws;
    const float* x = a.in[0]; const float* g_attn = a.in[1]; const float* w_in = a.in[2]; const float* b_forget = a.in[3];
    const float* g_ffn = a.in[10]; const float* wr_g = a.in[11]; const float* wr_e = a.in[13];
    const int gw = F.vcu * NWAVES + F.wave, NGW = F.G * NWAVES, lane = F.lane;
    LAS float* wfL = (LAS float*)(F.lds + RING_OFF + 8 * 8704);
    for (int k = F.tid; k < DM; k += NWAVES * 64) { const float gk = g_attn[k]; const float* wp = w_in + (size_t)k * DIN + NPROJ;
        const f32x4 u0 = *(const f32x4*)(wp) * gk, u1 = *(const f32x4*)(wp + 4) * gk; *(LAS f32x4*)(wfL + 8 * k) = u0; *(LAS f32x4*)(wfL + 8 * k + 4) = u1; }
    LDS_WAIT(); __syncthreads();
    {
        f32x4 wf[16][2];
#pragma unroll
        for (int jj = 0; jj < 4; ++jj)
#pragma unroll
            for (int c = 0; c < 4; ++c) { const LAS float* p = wfL + 8 * (4 * lane + c + 256 * jj); wf[jj * 4 + c][0] = *(const LAS f32x4*)p; wf[jj * 4 + c][1] = *(const LAS f32x4*)(p + 4); }
        bf16* XN = (bf16*)(ws + WS_XN); float* FLOG = (float*)(ws + WS_FLOG);
        const float bfg = b_forget[lane & 7];
        f32x4 v[4], vn[4];
        if (gw < M) { const GAS f32x4* xr = (const GAS f32x4*)(x + (size_t)gw * DM) + lane;
#pragma unroll
            for (int j = 0; j < 4; ++j) vn[j] = xr[64 * j]; }
        for (int m = gw; m < M; m += NGW) {
#pragma unroll
            for (int j = 0; j < 4; ++j) v[j] = vn[j];
            if (m + NGW < M) { const GAS f32x4* xr = (const GAS f32x4*)(x + (size_t)(m + NGW) * DM) + lane;
#pragma unroll
                for (int j = 0; j < 4; ++j) vn[j] = xr[64 * j]; }
            float s2 = 0.f;
#pragma unroll
            for (int j = 0; j < 4; ++j) s2 += (v[j].x * v[j].x + v[j].y * v[j].y) + (v[j].z * v[j].z + v[j].w * v[j].w);
            const float rstd = 1.0f / sqrtf(wave_sum_fast(s2) * (1.f / DM) + EPS);
            f32x4 d0 = (f32x4){0.f, 0.f, 0.f, 0.f}, d1 = d0;
#pragma unroll
            for (int j = 0; j < 4; ++j)
#pragma unroll
                for (int c = 0; c < 4; ++c) { d0 += wf[j * 4 + c][0] * v[j][c]; d1 += wf[j * 4 + c][1] * v[j][c]; }
            float fl = 0.f;
#pragma unroll
            for (int q = 0; q < 4; ++q) { const float a0 = wave_sum_fast(d0[q]), a1 = wave_sum_fast(d1[q]); if (lane == q) fl = a0; if (lane == 4 + q) fl = a1; }
            if (lane < 8) { const float z = fl * rstd + bfg; const float az = fabsf(z);
                const float lf = fminf(z, 0.f) - log1pf(expf(-az));
                const int b = m >> 12, t = m & 4095; FLOG[(b * 8 + lane) * 4096 + t] = lf; }
            GAS unsigned long long* o8 = (GAS unsigned long long*)(XN + (size_t)m * DM) + lane;
#pragma unroll
            for (int j = 0; j < 4; ++j) o8[64 * j] = (unsigned long long)cvtpk_hw(v[j].x * rstd, v[j].y * rstd) | ((unsigned long long)cvtpk_hw(v[j].z * rstd, v[j].w * rstd) << 32);
        }
    }
    {
        const int gt = F.vcu * (NWAVES * 64) + F.tid, NGT = F.G * NWAVES * 64;
        float* rope = (float*)(ws + WS_ROPE);
        for (int i = gt; i < 4096 * 32; i += NGT) { const int pos = i >> 5, j = i & 31;
            const float inv = 1.0f / powf(10000.0f, (float)(2 * j) / 64.0f); const float ang = (float)pos * inv;
            float s, c; sincosf(ang, &s, &c); rope[pos * 64 + j] = c; rope[pos * 64 + 32 + j] = s; }
        float* WR = (float*)(ws + WS_WR);
        for (int i = gt; i < 1024 * 32; i += NGT) { const int k = i >> 5, j = i & 31; float v = 0.f;
            if (j < 4) v = wr_g[k * 4 + j] * g_ffn[k]; else if (j < 20) v = wr_e[k * 16 + (j - 4)] * g_ffn[k];
            WR[i] = v; }
    }
    {
        constexpr int NITEMS = 16 * 96 + 16 * 32 + 16 * 2 * 16 * 16 + 16 * 8 * 32;
        LAS float* scr = (LAS float*)(F.lds + RING_OFF + F.wave * 8704);
        float bufv[32]; TrItem cur, nx;
        int it = gw;
        if (it < NITEMS) { cur = tr_decode(it, a, lane);
#pragma unroll
            for (int i = 0; i < 32; ++i) bufv[i] = cur.src[(size_t)(2 * i) * cur.ldw]; }
        while (it < NITEMS) {
            const int nit = it + NGW;
#pragma unroll
            for (int i = 0; i < 32; ++i) scr[(2 * i + (lane >> 5)) * 33 + (lane & 31)] = bufv[i];
            const int c = lane & 7;
            f32x4 g0 = (f32x4){1.f, 1.f, 1.f, 1.f}, g1 = g0;
            if (cur.gk) { g0 = *(const f32x4*)(cur.gk + 8 * c); g1 = *(const f32x4*)(cur.gk + 8 * c + 4); }
            if (nit < NITEMS) { nx = tr_decode(nit, a, lane);
#pragma unroll
                for (int i = 0; i < 32; ++i) bufv[i] = nx.src[(size_t)(2 * i) * nx.ldw]; }
            LDS_WAIT(); asm volatile("" ::: "memory");
#pragma unroll
            for (int j = 0; j < 4; ++j) { const int n = (lane >> 3) + 8 * j; const LAS float* s = scr + (8 * c) * 33 + n;
                v4u o; o.x = cvtpk_hw(s[0 * 33] * g0.x, s[1 * 33] * g0.y); o.y = cvtpk_hw(s[2 * 33] * g0.z, s[3 * 33] * g0.w);
                o.z = cvtpk_hw(s[4 * 33] * g1.x, s[5 * 33] * g1.y); o.w = cvtpk_hw(s[6 * 33] * g1.z, s[7 * 33] * g1.w);
                *(GAS v4u*)(cur.dst + (size_t)n * cur.K + 8 * c) = o; }
            LDS_WAIT(); asm volatile("" ::: "memory");
            cur = nx; it = nit;
        }
    }
}

__device__ __forceinline__ void p1_scan(Frame& F, const Args& a) {
    const float* FLOG = (const float*)(a.ws + WS_FLOG); float* GLo = (float*)(a.ws + WS_GL);
    LAS float* wsum = (LAS float*)(F.lds + RING_OFF);
    for (int bh = blockIdx.x; bh < 32; bh += F.G) {
        const f32x4* src = (const f32x4*)(FLOG + bh * 4096 + F.tid * 8);
        f32x4 u0 = src[0], u1 = src[1];
        float p[8]; p[0] = u0.x; p[1] = p[0] + u0.y; p[2] = p[1] + u0.z; p[3] = p[2] + u0.w; p[4] = p[3] + u1.x; p[5] = p[4] + u1.y; p[6] = p[5] + u1.z; p[7] = p[6] + u1.w;
        float incl = p[7];
#pragma unroll
        for (int o = 1; o < 64; o <<= 1) { const float nb = __shfl_up(incl, o); if (F.lane >= o) incl += nb; }
        if (F.lane == 63) wsum[F.wave] = incl;
        LDS_WAIT(); __syncthreads();
        float base = incl - p[7];
        for (int w = 0; w < F.wave; ++w) base += wsum[w];
        f32x4 o0, o1; o0.x = -LOG2E * (base + p[0]); o0.y = -LOG2E * (base + p[1]); o0.z = -LOG2E * (base + p[2]); o0.w = -LOG2E * (base + p[3]);
        o1.x = -LOG2E * (base + p[4]); o1.y = -LOG2E * (base + p[5]); o1.z = -LOG2E * (base + p[6]); o1.w = -LOG2E * (base + p[7]);
        f32x4* dst = (f32x4*)(GLo + bh * 4096 + F.tid * 8); dst[0] = o0; dst[1] = o1;
        LDS_WAIT(); __syncthreads();
    }
    VM_WAIT(); __syncthreads();
}

__device__ __forceinline__ void p25_diffnorm(Frame& F, const Args& a) {
    const bf16* DD = (const bf16*)(a.ws + WS_DD); const float* SS = (const float*)(a.ws + WS_SS); bf16* OA = (bf16*)(a.ws + WS_OA); const float* gd = a.in[8];
    const int gt = F.vcu * (NWAVES * 64) + F.tid, NGT = F.G * NWAVES * 64;
    for (int i = gt; i < M * 64; i += NGT) {
        const int tok = i >> 6, ch = i & 63, h = ch >> 4;
        const v4u d = *(const v4u*)(DD + (size_t)tok * 512 + 8 * ch);
        const float ss = SS[tok * 8 + 2 * h] + SS[tok * 8 + 2 * h + 1];
        const float s = (1.0f - LAM_INIT) / sqrtf(ss * (1.f / 128.f) + EPS);
        const float* gp = gd + ((8 * ch) & 127);
        const f32x4 g0 = *(const f32x4*)gp, g1 = *(const f32x4*)(gp + 4);
        v4u o; o.x = pk2(bflo(d.x) * s * g0.x, bfhi(d.x) * s * g0.y); o.y = pk2(bflo(d.y) * s * g0.z, bfhi(d.y) * s * g0.w);
        o.z = pk2(bflo(d.z) * s * g1.x, bfhi(d.z) * s * g1.y); o.w = pk2(bflo(d.w) * s * g1.z, bfhi(d.w) * s * g1.w);
        *(v4u*)(OA + (size_t)tok * 1024 + 8 * ch) = o;
    }
}

__device__ __forceinline__ void p35_route(Frame& F, const Args& a) {
    const bf16* X1B = (const bf16*)(a.ws + WS_X1B); const float* WR = (const float*)(a.ws + WS_WR);
    const float* bg = a.in[12]; const float* be = a.in[14];
    int* LIST = (int*)(a.ws + WS_LIST); int* TOKI = (int*)(a.ws + WS_TOKI); float* TOKW = (float*)(a.ws + WS_TOKW); float* R2 = (float*)(a.ws + WS_R2);
    LAS float* T = (LAS float*)(F.lds + RING_OFF);
    LAS int* lcnt = (LAS int*)(F.lds + RING_OFF + 8 * 64 * 24 * 4);
    for (int tb = F.vcu; tb < M / 64; tb += F.G) {
        const int tok = tb * 64 + F.lane;
        float acc[21];
#pragma unroll
        for (int j = 0; j < 21; ++j) acc[j] = 0.f;
        const bf16* xr = X1B + (size_t)tok * DM + 128 * F.wave;
        const float* wbase = WR + (size_t)(128 * F.wave) * 32;
        for (int rep35 = 0; rep35 < REPS(5); ++rep35)
        for (int kk = 0; kk < 128; kk += 8) {
            if (kk == 0) {
#pragma unroll
                for (int j = 0; j < 21; ++j) acc[j] = 0.f; }
            const v4u xv = *(const v4u*)(xr + kk);
            float xf[8] = {bflo(xv.x), bfhi(xv.x), bflo(xv.y), bfhi(xv.y), bflo(xv.z), bfhi(xv.z), bflo(xv.w), bfhi(xv.w)};
#pragma unroll
            for (int i = 0; i < 8; ++i) {
                const float* wp = wbase + (kk + i) * 32;
                const f32x4 w0 = *(const f32x4*)(wp), w1 = *(const f32x4*)(wp + 4), w2 = *(const f32x4*)(wp + 8), w3 = *(const f32x4*)(wp + 12), w4 = *(const f32x4*)(wp + 16);
                acc[20] += xf[i] * xf[i];
#pragma unroll
                for (int j = 0; j < 4; ++j) { acc[j] += xf[i] * w0[j]; acc[4 + j] += xf[i] * w1[j]; acc[8 + j] += xf[i] * w2[j]; acc[12 + j] += xf[i] * w3[j]; acc[16 + j] += xf[i] * w4[j]; }
            }
        }
#pragma unroll
        for (int j = 0; j < 21; ++j) T[(F.wave * 64 + F.lane) * 24 + j] = acc[j];
        if (F.tid < 16) lcnt[F.tid] = 0;
        LDS_WAIT(); __syncthreads();
        int e0 = 0, e1 = 0, rk0 = 0, rk1 = 0; float w0 = 0.f, w1 = 0.f;
        if (F.wave == 0) {
            float s[21];
#pragma unroll
            for (int j = 0; j < 21; ++j) { float v = 0.f;
#pragma unroll
                for (int w = 0; w < 8; ++w) v += T[(w * 64 + F.lane) * 24 + j];
                s[j] = v; }
            const float r = 1.0f / sqrtf(s[20] * (1.f / DM) + EPS);
            float gl[4];
#pragma unroll
            for (int j = 0; j < 4; ++j) gl[j] = s[j] * r + bg[j];
            int g = 0; float gm = gl[0];
#pragma unroll
            for (int j = 1; j < 4; ++j) if (gl[j] > gm) { gm = gl[j]; g = j; }
            float den = 0.f;
#pragma unroll
            for (int j = 0; j < 4; ++j) den += expf(gl[j] - gm);
            const float gw = 1.0f / den;
            float el[4];
#pragma unroll
            for (int i = 0; i < 4; ++i) { float v = s[4 + i]; v = (g == 1) ? s[8 + i] : v; v = (g == 2) ? s[12 + i] : v; v = (g == 3) ? s[16 + i] : v;
                float bb = be[i]; bb = (g == 1) ? be[4 + i] : bb; bb = (g == 2) ? be[8 + i] : bb; bb = (g == 3) ? be[12 + i] : bb; el[i] = v * r + bb; }
            int i0 = 0; float v0 = el[0];
#pragma unroll
            for (int i = 1; i < 4; ++i) if (el[i] > v0) { v0 = el[i]; i0 = i; }
            int i1 = -1; float v1 = 0.f;
#pragma unroll
            for (int i = 0; i < 4; ++i) if (i != i0 && (i1 < 0 || el[i] > v1)) { v1 = el[i]; i1 = i; }
            const float p0 = 1.0f / (1.0f + expf(v1 - v0));
            w0 = gw * p0; w1 = gw * (1.0f - p0); e0 = 4 * g + i0; e1 = 4 * g + i1;
            rk0 = __hip_atomic_fetch_add(lcnt + e0, 1, __ATOMIC_RELAXED, __HIP_MEMORY_SCOPE_WORKGROUP);
            rk1 = __hip_atomic_fetch_add(lcnt + e1, 1, __ATOMIC_RELAXED, __HIP_MEMORY_SCOPE_WORKGROUP);
            R2[tok] = r;
        }
        LDS_WAIT(); __syncthreads();
        if (F.tid < 16) { const int n = lcnt[F.tid]; int base = 0; if (n > 0) base = (int)__hip_atomic_fetch_add((unsigned*)(F.ctl + CW_CNT + 64 * F.tid), (unsigned)n, RLX_AGENT); lcnt[16 + F.tid] = base; }
        LDS_WAIT(); __syncthreads();
        if (F.wave == 0) {
            rk0 += lcnt[16 + e0]; rk1 += lcnt[16 + e1];
            LIST[e0 * LISTCAP + (rk0 & (LISTCAP - 1))] = tok; LIST[e1 * LISTCAP + (rk1 & (LISTCAP - 1))] = tok;
            *(int4*)(TOKI + 4 * tok) = make_int4(e0, rk0, e1, rk1);
            *(float2*)(TOKW + 2 * tok) = make_float2(w0, w1);
        }
        LDS_WAIT(); __syncthreads();
    }
}

__device__ __forceinline__ void p6_final(Frame& F, const Args& a) {
    const bf16* X1B = (const bf16*)(a.ws + WS_X1B); const bf16* Y = (const bf16*)(a.ws + WS_Y);
    const int* TOKI = (const int*)(a.ws + WS_TOKI); const float* TOKW = (const float*)(a.ws + WS_TOKW); const float* gf = a.in[18];
    int base[16]; { int acc = 0;
#pragma unroll
        for (int e = 0; e < 16; ++e) { int c = (int)__builtin_amdgcn_readfirstlane(__hip_atomic_load(F.ctl + CW_CNT + 64 * e, RLX_AGENT)); if (c > 16384) c = 16384; base[e] = acc * 256; acc += (c + 255) >> 8; } }
    const int gw = F.vcu * NWAVES + F.wave, NGW = F.G * NWAVES, lane = F.lane;
    f32x4 g4[4];
#pragma unroll
    for (int j = 0; j < 2; ++j) { g4[2 * j] = *(const f32x4*)(gf + 512 * j + 8 * lane); g4[2 * j + 1] = *(const f32x4*)(gf + 512 * j + 8 * lane + 4); }
    for (int m = gw; m < M; m += NGW) {
        const int4 ti = *(const int4*)(TOKI + 4 * m); const float2 tw = *(const float2*)(TOKW + 2 * m);
        const int e0 = __builtin_amdgcn_readfirstlane(ti.x), r0 = __builtin_amdgcn_readfirstlane(ti.y), e1 = __builtin_amdgcn_readfirstlane(ti.z), r1 = __builtin_amdgcn_readfirstlane(ti.w);
        int b0 = 0, b1 = 0;
#pragma unroll
        for (int e = 0; e < 16; ++e) { b0 = (e0 == e) ? base[e] : b0; b1 = (e1 == e) ? base[e] : b1; }
        const bf16* xp = X1B + (size_t)m * DM + 8 * lane; const bf16* y0 = Y + (size_t)(b0 + r0) * DM + 8 * lane; const bf16* y1 = Y + (size_t)(b1 + r1) * DM + 8 * lane;
        float v[16]; float s2 = 0.f;
#pragma unroll
        for (int j = 0; j < 2; ++j) {
            const v4u xv = *(const v4u*)(xp + 512 * j), ya = *(const v4u*)(y0 + 512 * j), yb = *(const v4u*)(y1 + 512 * j);
#pragma unroll
            for (int q = 0; q < 4; ++q) { v[8 * j + 2 * q] = bflo(xv[q]) + tw.x * bflo(ya[q]) + tw.y * bflo(yb[q]); v[8 * j + 2 * q + 1] = bfhi(xv[q]) + tw.x * bfhi(ya[q]) + tw.y * bfhi(yb[q]); }
        }
#pragma unroll
        for (int i = 0; i < 16; ++i) s2 += v[i] * v[i];
        const float rstd = 1.0f / sqrtf(wave_sum(s2) * (1.f / DM) + EPS);
        float* op = a.out + (size_t)m * DM + 8 * lane;
#pragma unroll
        for (int j = 0; j < 2; ++j) {
            f32x4 oa, ob;
#pragma unroll
            for (int q = 0; q < 4; ++q) { oa[q] = v[8 * j + q] * rstd * g4[2 * j][q]; ob[q] = v[8 * j + 4 + q] * rstd * g4[2 * j + 1][q]; }
            *(f32x4*)(op + 512 * j) = oa; *(f32x4*)(op + 512 * j + 4) = ob;
        }
    }
}

__global__ void __launch_bounds__(NWAVES * 64, 2) mk_fwd(Args args) {
    extern __shared__ __attribute__((aligned(16))) unsigned char lds[];
    Frame F;
    F.lds = (LAS unsigned char*)lds;
    F.MISC = (volatile LAS unsigned*)(F.lds + MISC_OFF);
    F.tid = threadIdx.x; F.lane = F.tid & 63; F.wave = __builtin_amdgcn_readfirstlane(F.tid >> 6);
    F.G = gridDim.x; { const int bx = blockIdx.x; F.vcu = (F.G % 8 == 0) ? (bx % 8) * (F.G / 8) + bx / 8 : bx; }
    unsigned char* ws = args.ws;
    F.ctl = (gu32*)(ws + WS_CTL);
    for (int u = F.tid; u < (LDS_BYTES - LDSCTL_OFF) / 4; u += NWAVES * 64) ((LAS unsigned*)(F.lds + LDSCTL_OFF))[u] = 0u;
    __syncthreads();
    XcdBarrier bar = xcd_barrier_post((unsigned*)(F.ctl + CW_BAR), F.MISC + 8);
#define GRID_BAR() do { xcd_barrier(bar); if (REPS(9) == 2) xcd_barrier(bar); } while (0)

    if (REPS(0) == 2) { p0_prologue(F, args); __syncthreads(); }
    p0_prologue(F, args);
    GRID_BAR();

    if (PHM & 2) p1_scan(F, args);
    for (int rep = 0; rep < REPS(1); ++rep) {
        pg8::Gemm g{(const pg8::bf16_t*)(ws + WS_XN), (const pg8::bf16_t*)(ws + WS_WIN), DM};
        pg8::StaticOrder S; S.init(M, NPROJ, F.G, (int)blockIdx.x);
        epi::EpiProj E{(pg8::bf16_t*)(ws + WS_QKV), QKV_STRIDE / 2, (const float*)(ws + WS_ROPE), attn_body::C2};
        pg8::gemm_phase<epi::EpiProj, pg8::StaticOrder, true>(F.lds + RING_OFF, g, S, E);
    }
    GRID_BAR();

    for (int rep = 0; rep < REPS(2); ++rep) {
        using abf = attn_body::bf16;
        const abf* QD = (const abf*)(ws + WS_QKV); const abf* KD = QD + QKV_STRIDE / 2; const abf* VD = KD + QKV_STRIDE / 2;
        const abf* QF = VD + QKV_STRIDE / 2; const abf* KF = QF + QKV_STRIDE / 2; const abf* VF = KF + QKV_STRIDE / 2;
        abf* OA = (abf*)(ws + WS_OA); abf* DDp = (abf*)(ws + WS_DD); float* SS = (float*)(ws + WS_SS); const float* GLp = (const float*)(ws + WS_GL);
        float lam;
        { const float a1 = wave_sum(args.in[4][F.lane] * args.in[5][F.lane]), a2 = wave_sum(args.in[6][F.lane] * args.in[7][F.lane]); lam = expf(a1) - expf(a2) + LAM_INIT; }
        char* shm = (char*)lds + RING_OFF;
        for (int it = F.vcu; it < 512; it += F.G) {
            if ((AMM & 1) && it >= 256) {
                const int dp = it - 256, bh = dp >> 4, hf = (dp >> 3) & 1, s = dp & 7, b = bh >> 2, h = bh & 3;
                const long rowbase = (long)b * SEQ;
                for (int k = 0; k < 2; ++k) { const int qb = k ? s : 15 - s;
                    attn_body::attn_unit<1, 8>(rowbase, qb, QD + h * 128, KD + h * 128, VD + h * 128 + hf * 64, DDp, 512, nullptr, 0.f, nullptr, shm);
                    attn_body::attn_unit<2, 8>(rowbase, qb, QD + h * 128 + 64, KD + h * 128 + 64, VD + h * 128 + hf * 64, DDp + h * 128 + hf * 64, 512, nullptr, lam, SS + h * 2 + hf, shm); }
            } else if (AMM & 2) {
                const int bh = it >> 3, s = it & 7, b = bh >> 3, h = bh & 7;
                const long rowbase = (long)b * SEQ;
                for (int k = 0; k < 2; ++k) { const int qb = k ? s : 15 - s;
                    attn_body::attn_unit<0, 8>(rowbase, qb, QF + h * 64, KF + h * 64, VF + h * 64, OA + 512 + h * 64, 1024, GLp + bh * 4096, 0.f, nullptr, shm); }
            }
        }
    }
    GRID_BAR();

    for (int rep = 0; rep < REPS(3); ++rep) p25_diffnorm(F, args);
    GRID_BAR();

    for (int rep = 0; rep < REPS(4); ++rep) {
        pg8::Gemm g{(const pg8::bf16_t*)(ws + WS_OA), (const pg8::bf16_t*)(ws + WS_WOUT), DM};
        pg8::StaticOrder S; S.init(M, DM, F.G, (int)blockIdx.x);
        epi::EpiRes E{args.in[0], (pg8::bf16_t*)(ws + WS_X1B)};
        pg8::gemm_phase<epi::EpiRes, pg8::StaticOrder, true>(F.lds + RING_OFF, g, S, E);
    }
    GRID_BAR();

    p35_route(F, args);
    GRID_BAR();

    for (int rep = 0; rep < REPS(6); ++rep) {
        pg8::Gemm g{(const pg8::bf16_t*)(ws + WS_X1B), (const pg8::bf16_t*)(ws + WS_WGU), DM};
        pg8::ExpertOrder<true> S; S.init((const unsigned*)(F.ctl + CW_CNT), F.G, (int)blockIdx.x, (const int*)(ws + WS_LIST));
        epi::EpiSwiglu E{(pg8::bf16_t*)(ws + WS_ACT), (const int*)(ws + WS_LIST), (const float*)(ws + WS_R2)};
        pg8::gemm_phase<epi::EpiSwiglu, pg8::ExpertOrder<true>, true>(F.lds + RING_OFF, g, S, E);
    }
    GRID_BAR();

    for (int rep = 0; rep < REPS(7); ++rep) {
        pg8::Gemm g{(const pg8::bf16_t*)(ws + WS_ACT), (const pg8::bf16_t*)(ws + WS_WD), DEXP};
        pg8::ExpertOrder<false> S; S.init((const unsigned*)(F.ctl + CW_CNT), F.G, (int)blockIdx.x, nullptr);
        epi::EpiY E{(pg8::bf16_t*)(ws + WS_Y)};
        pg8::gemm_phase<epi::EpiY, pg8::ExpertOrder<false>, true>(F.lds + RING_OFF, g, S, E);
    }
    GRID_BAR();

    for (int rep = 0; rep < REPS(8); ++rep) p6_final(F, args);
}

extern "C" void kernel_launch(void* const* d_in, const int* in_sizes, int n_in, void* d_out, int out_size, void* d_ws, size_t ws_size, hipStream_t stream) {
    static int grid = 0;
    if (grid == 0) {
        if (n_in != 19 || in_sizes[0] != M * DM || out_size != M * DM || ws_size < WS_END) { fprintf(stderr, "kernel_launch: unexpected shapes (n_in %d, in0 %d, out %d, ws %zu); nothing launched\n", n_in, n_in > 0 ? in_sizes[0] : -1, out_size, ws_size); grid = -1; return; }
        int dev = 0, cus = 0, per_cu = 0;
        if (hipGetDevice(&dev) != hipSuccess || hipDeviceGetAttribute(&cus, hipDeviceAttributeMultiprocessorCount, dev) != hipSuccess) { grid = -1; return; }
        if (hipFuncSetAttribute((const void*)mk_fwd, hipFuncAttributeMaxDynamicSharedMemorySize, LDS_BYTES) != hipSuccess) { fprintf(stderr, "kernel_launch: hipFuncSetAttribute failed\n"); grid = -1; return; }
        if (hipOccupancyMaxActiveBlocksPerMultiprocessor(&per_cu, (const void*)mk_fwd, NWAVES * 64, LDS_BYTES) != hipSuccess || per_cu < 1) { fprintf(stderr, "kernel_launch: occupancy query says %d blocks per CU\n", per_cu); (void)hipGetLastError(); grid = -1; return; }
        grid = cus;
    }
    if (grid < 0) return;
    if (hipMemsetAsync((char*)d_ws + WS_CTL, 0, CTL_ZERO_BYTES, stream) != hipSuccess) { fprintf(stderr, "kernel_launch: hipMemsetAsync failed\n"); return; }
    Args a{};
    for (int i = 0; i < 19; ++i) a.in[i] = (const float*)d_in[i];
    a.out = (float*)d_out; a.ws = (unsigned char*)d_ws;
#ifndef MK_COOP
#define MK_COOP 1
#endif
#if MK_COOP
    void* kargs[] = {&a};
    hipError_t e = hipLaunchCooperativeKernel((const void*)mk_fwd, dim3(grid), dim3(NWAVES * 64), kargs, LDS_BYTES, stream);
    if (e != hipSuccess) fprintf(stderr, "kernel_launch: cooperative launch failed: %s (grid %d)\n", hipGetErrorString(e), grid);
#else
    hipLaunchKernelGGL(mk_fwd, dim3(grid), dim3(NWAVES * 64), LDS_BYTES, stream, a);
    const hipError_t e = hipPeekAtLastError();
    if (e != hipSuccess) fprintf(stderr, "kernel_launch: launch failed: %s (grid %d)\n", hipGetErrorName(e), grid);
#endif
}
```

```cpp
#include <hip/hip_runtime.h>
#include <hip/hip_bf16.h>
#include <cstdio>
#include <cstdint>
#include <cmath>
namespace pg8 {
#define PG8_LAS __attribute__((address_space(3)))
typedef unsigned short bf16_t;
typedef short bf16x8 __attribute__((ext_vector_type(8)));
typedef float f32x4 __attribute__((ext_vector_type(4)));
typedef unsigned u32x4 __attribute__((ext_vector_type(4)));
constexpr int BM = 256, BK = 64, HALF = 128, HTB = HALF * BK * 2  , STAGE_BYTES = 8 * HTB, NXCD = 8, WGM = 8;

__host__ __device__ __forceinline__ int lds_byte(int r, int c) { const int st = (r >> 4) * 2 + (c >> 5), rr = r & 15, cc = c & 31, ob = rr * 64 + cc * 2; return st * 1024 + (ob ^ (((ob >> 9) & 1) << 5)); }
__host__ __device__ __forceinline__ void stage_rc(int b, int& R, int& C) { const int st = b / 1024, sb = b % 1024, swz = sb ^ (((sb >> 9) & 1) << 5); R = (st >> 1) * 16 + swz / 64; C = (st & 1) * 32 + (swz % 64) / 2; }
__host__ __device__ __forceinline__ int perm32(int rho) { const int n = rho >> 4, i = rho & 15; return 8 * (i >> 2) + 4 * n + (i & 3); }

struct Unit { int pm, pn, bn, nv, e, mt; };
struct Gemm { const bf16_t* A; const bf16_t* Bt; int K; };

struct StaticOrder {
    int nM, nN, nwg, G, c;
    __device__ void init(int M, int N, int G_, int c_) { nM = M / BM; nN = N / BM; nwg = nM * nN; G = G_; c = c_; }
    __device__ __forceinline__ bool next(int i, Unit& u) const {
        const long L = (long)i * G + c; if (L >= nwg) return false;
        int wgid = (int)L; { const int q = nwg / NXCD, r = nwg % NXCD, xcd = wgid % NXCD, off = wgid / NXCD; wgid = (xcd < r ? xcd * (q + 1) : r * (q + 1) + (xcd - r) * q) + off; }
        const int nig = WGM * nN, gid = wgid / nig, fm = gid * WGM, gsz = (nM - fm) < WGM ? (nM - fm) : WGM;
        u.pm = fm + ((wgid % nig) % gsz); u.pn = (wgid % nig) / gsz; u.bn = u.pn; u.nv = BM; u.e = 0; u.mt = 0; return true;
    }
    __device__ __forceinline__ void aoff(const Unit& u, const int (&R)[2], const int (&C)[2], int K, unsigned (&vo)[2][2]) const {
#pragma unroll
        for (int h = 0; h < 2; ++h)
#pragma unroll
            for (int i = 0; i < 2; ++i) vo[h][i] = (unsigned)((u.pm * BM + h * HALF + R[i]) * K + C[i]) * 2u;
    }
};

template <bool GATHER> struct ExpertOrder {
    int cnt[16]; int T, G, c; const int* list;
    __device__ __forceinline__ void init(const unsigned* cw, int G_, int c_, const int* list_) {
        T = 0;
#pragma unroll
        for (int e = 0; e < 16; ++e) { cnt[e] = (int)__builtin_amdgcn_readfirstlane(__hip_atomic_load(cw + 64 * e, __ATOMIC_RELAXED, __HIP_MEMORY_SCOPE_AGENT)); if (cnt[e] > 16384) cnt[e] = 16384; T += (cnt[e] + 255) >> 8; }
        G = G_; c = c_; list = list_;
    }
    __device__ __forceinline__ bool next(int i, Unit& u) const {
        const int L = i * G + c; if (L >= 4 * T) return false;
        const int rt = L >> 2; int acc = 0; u.e = 0; u.mt = 0; u.nv = 0;
#pragma unroll
        for (int e = 0; e < 16; ++e) { const int te = (cnt[e] + 255) >> 8; if (rt >= acc && rt < acc + te) { u.e = e; u.mt = rt - acc; const int left = cnt[e] - u.mt * 256; u.nv = left < 256 ? left : 256; } acc += te; }
        u.pm = rt; u.pn = L & 3; u.bn = u.e * 4 + u.pn; return true;
    }
    __device__ __forceinline__ void aoff(const Unit& u, const int (&R)[2], const int (&C)[2], int K, unsigned (&vo)[2][2]) const {
#pragma unroll
        for (int h = 0; h < 2; ++h)
#pragma unroll
            for (int i = 0; i < 2; ++i) {
                int row;
                if constexpr (GATHER) { const int rt = h * HALF + R[i]; row = 0; if (rt < u.nv) row = list[u.e * 16384 + u.mt * 256 + rt]; row &= 16383; }
                else row = u.pm * BM + h * HALF + R[i];
                vo[h][i] = (unsigned)(row * K + C[i]) * 2u;
            }
    }
};

__device__ __forceinline__ unsigned cvt_pk_bf16(float lo, float hi) { unsigned r; asm volatile("v_cvt_pk_bf16_f32 %0, %1, %2" : "=v"(r) : "v"(lo), "v"(hi)); return r; }

template <class Epi, class Sched, bool ALIGN_EPI>
__device__ __forceinline__ void gemm_phase(PG8_LAS unsigned char* lds, const Gemm g, const Sched& S, const Epi& E) {
    int tid_ = threadIdx.x; asm volatile("" : "+v"(tid_));
    const int tid = tid_, wid = __builtin_amdgcn_readfirstlane(tid >> 6), lane = tid & 63, wr = wid >> 2, wc = wid & 3, fr = lane & 15, fq = lane >> 4;
    const int K = g.K, nt = K / BK;
    int Rr[2], Cc[2]; unsigned voffB[2];
#pragma unroll
    for (int i = 0; i < 2; ++i) { int R, C; stage_rc(tid * 16 + i * 8192, R, C); Rr[i] = R; Cc[i] = C; const int Rb = (R & ~31) + perm32(R & 31); voffB[i] = (unsigned)(Rb * K + C) * 2u; }
    const unsigned kstep = (unsigned)(BK * 2);
    const size_t hstep = (size_t)HALF * K * 2;
    const size_t tstep = 2 * hstep;
    const unsigned ldsw = (unsigned)wid * 1024u;
    const int aoff = lds_byte(wr * 64 + fr, fq * 8), boff = lds_byte(wc * 32 + fr, fq * 8);
    const char* const Abase = (const char*)g.A;
#define PG8_SA(b, h) (((b) * 2 + (h)) * HTB)
#define PG8_SB(b, h) ((4 + (b) * 2 + (h)) * HTB)
#define PG8_STAGE(bufoff, gbase, voff) do { _Pragma("unroll") for (int _i = 0; _i < 2; ++_i) \
        __builtin_amdgcn_global_load_lds((const unsigned*)((const char*)(gbase) + (voff)[_i]), (PG8_LAS unsigned*)(lds + (bufoff) + ldsw + _i * 8192), 16, 0, 0); } while (0)
#define PG8_LDA(dst, b, h) do { _Pragma("unroll") for (int m = 0; m < 4; ++m) _Pragma("unroll") for (int k = 0; k < 2; ++k) dst[m][k] = *(const PG8_LAS bf16x8*)(lds + PG8_SA(b, h) + aoff + m * 2048 + k * 1024); } while (0)
#define PG8_LDB(dst, b, h) do { _Pragma("unroll") for (int n = 0; n < 2; ++n) _Pragma("unroll") for (int k = 0; k < 2; ++k) dst[n][k] = *(const PG8_LAS bf16x8*)(lds + PG8_SB(b, h) + boff + n * 2048 + k * 1024); } while (0)
#define PG8_MMA(ai, bj, At, Bt) do { __builtin_amdgcn_s_setprio(1); _Pragma("unroll") for (int m = 0; m < 4; ++m) _Pragma("unroll") for (int n = 0; n < 2; ++n) _Pragma("unroll") for (int k = 0; k < 2; ++k) \
        acc[ai][bj][m][n] = __builtin_amdgcn_mfma_f32_16x16x32_bf16(Bt[n][k], At[m][k], acc[ai][bj][m][n], 0, 0, 0); __builtin_amdgcn_s_setprio(0); } while (0)
#define PG8_WAIT_V(n) asm volatile("s_waitcnt vmcnt(" #n ")" ::: "memory")
#define PG8_WAIT_L(n) asm volatile("s_waitcnt lgkmcnt(" #n ")" ::: "memory")
#define PG8_BAR __builtin_amdgcn_s_barrier()
#define PG8_SCHED __builtin_amdgcn_sched_barrier(0)
    Unit cur, nxt; int ui = 0;
    if (!S.next(0, cur)) return;
    f32x4 acc[2][2][4][2];
#pragma unroll
    for (int a = 0; a < 2; ++a)
#pragma unroll
        for (int b = 0; b < 2; ++b)
#pragma unroll
            for (int m = 0; m < 4; ++m)
#pragma unroll
                for (int n = 0; n < 2; ++n) acc[a][b][m][n] = (f32x4){0.f, 0.f, 0.f, 0.f};
    bf16x8 At[4][2], B0[2][2], B1[2][2];
    unsigned vAc[2][2], vAn[2][2];
    S.aoff(cur, Rr, Cc, K, vAc);
    const char* cB = (const char*)g.Bt + (size_t)cur.bn * tstep;
    PG8_STAGE(PG8_SB(0, 0), cB, voffB); PG8_STAGE(PG8_SB(0, 1), cB + hstep, voffB); PG8_STAGE(PG8_SA(0, 0), Abase, vAc[0]); PG8_STAGE(PG8_SA(0, 1), Abase, vAc[1]);
    if (wr == 1) PG8_BAR;
    PG8_WAIT_V(2); PG8_BAR;
    PG8_STAGE(PG8_SB(1, 0), cB + kstep, voffB); PG8_STAGE(PG8_SA(1, 0), Abase + kstep, vAc[0]); PG8_STAGE(PG8_SB(1, 1), cB + hstep + kstep, voffB);
    PG8_WAIT_V(6); PG8_BAR;
    for (;;) {
        const bool has_next = S.next(ui + 1, nxt);
        if (has_next) S.aoff(nxt, Rr, Cc, K, vAn);
        else {
#pragma unroll
            for (int h = 0; h < 2; ++h)
#pragma unroll
                for (int i = 0; i < 2; ++i) vAn[h][i] = vAc[h][i];
        }
        const char* nB = has_next ? (const char*)g.Bt + (size_t)nxt.bn * tstep : cB;
        for (int t = 0; t < nt; t += 2) {
            const bool last = (t == nt - 2);
            const char* a1 = Abase + (size_t)(t + 1) * kstep;
            const char* a2 = last ? Abase : Abase + (size_t)(t + 2) * kstep; const char* b2 = last ? nB : cB + (size_t)(t + 2) * kstep;
            const char* a3 = a2 + kstep; const char* b3 = b2 + kstep;
            unsigned v2[2][2];
#pragma unroll
            for (int h = 0; h < 2; ++h)
#pragma unroll
                for (int i = 0; i < 2; ++i) v2[h][i] = last ? vAn[h][i] : vAc[h][i];
            PG8_LDB(B0, 0, 0); PG8_LDB(B1, 0, 1); PG8_SCHED; PG8_LDA(At, 0, 0); PG8_STAGE(PG8_SA(1, 1), a1, vAc[1]);
            PG8_WAIT_V(8); PG8_WAIT_L(0); PG8_BAR; PG8_MMA(0, 0, At, B0); PG8_MMA(0, 1, At, B1); PG8_BAR; PG8_SCHED;
            PG8_LDA(At, 0, 1); PG8_STAGE(PG8_SB(0, 0), b2, voffB); PG8_STAGE(PG8_SB(0, 1), b2 + hstep, voffB); PG8_STAGE(PG8_SA(0, 0), a2, v2[0]);
            PG8_WAIT_V(8); PG8_WAIT_L(0); PG8_BAR; PG8_MMA(1, 0, At, B0); PG8_MMA(1, 1, At, B1); PG8_BAR; PG8_SCHED;
            PG8_LDB(B0, 1, 0); PG8_LDB(B1, 1, 1); PG8_SCHED; PG8_LDA(At, 1, 0); PG8_STAGE(PG8_SA(0, 1), a2, v2[1]);
            PG8_WAIT_V(8); PG8_WAIT_L(0); PG8_BAR; PG8_MMA(0, 0, At, B0); PG8_MMA(0, 1, At, B1); PG8_BAR; PG8_SCHED;
            PG8_LDA(At, 1, 1); PG8_STAGE(PG8_SB(1, 0), b3, voffB); PG8_STAGE(PG8_SB(1, 1), b3 + hstep, voffB); PG8_STAGE(PG8_SA(1, 0), a3, v2[0]);
            PG8_WAIT_V(8); PG8_WAIT_L(0); PG8_BAR; PG8_MMA(1, 0, At, B0); PG8_MMA(1, 1, At, B1); PG8_BAR; PG8_SCHED;
        }
        if constexpr (ALIGN_EPI) { if (wr == 0) PG8_BAR; }
        E(acc, cur, wr, wc, fr, fq);
        if (!has_next) break;
#pragma unroll
        for (int a = 0; a < 2; ++a)
#pragma unroll
            for (int b = 0; b < 2; ++b)
#pragma unroll
                for (int m = 0; m < 4; ++m)
#pragma unroll
                    for (int n = 0; n < 2; ++n) acc[a][b][m][n] = (f32x4){0.f, 0.f, 0.f, 0.f};
        cur = nxt; cB = nB; ++ui;
#pragma unroll
        for (int h = 0; h < 2; ++h)
#pragma unroll
            for (int i = 0; i < 2; ++i) vAc[h][i] = vAn[h][i];
        if constexpr (ALIGN_EPI) { if (wr == 1) PG8_BAR; }
    }
    PG8_WAIT_V(0);
    if constexpr (!ALIGN_EPI) { if (wr == 0) PG8_BAR; }
    PG8_BAR;
#undef PG8_SA
#undef PG8_SB
#undef PG8_STAGE
#undef PG8_LDA
#undef PG8_LDB
#undef PG8_MMA
#undef PG8_WAIT_V
#undef PG8_WAIT_L
#undef PG8_BAR
#undef PG8_SCHED
}
}
namespace epi {
using pg8::f32x4; using pg8::u32x4; using pg8::Unit; using pg8::bf16_t; using pg8::cvt_pk_bf16;
constexpr int BM = 256, HALF = 128;
__device__ __forceinline__ u32x4 pack8(const f32x4 a, const f32x4 b) { u32x4 w; w.x = cvt_pk_bf16(a[0], a[1]); w.y = cvt_pk_bf16(a[2], a[3]); w.z = cvt_pk_bf16(b[0], b[1]); w.w = cvt_pk_bf16(b[2], b[3]); return w; }

struct EpiProj {
    bf16_t* O; size_t stride; const float* rope; float c2;
    __device__ __forceinline__ void operator()(const f32x4 (&acc)[2][2][4][2], const Unit& u, int wr, int wc, int fr, int fq) const {
        const int kind = u.pn >> 1, hf = u.pn & 1;
        bf16_t* base = O + (size_t)kind * stride;
        const float sc = (kind == 0 || kind == 3) ? c2 : 1.f;
        const int row0 = u.pm * BM + wr * 64 + fr;
        if (kind < 2) {
#pragma unroll
            for (int ai = 0; ai < 2; ++ai)
#pragma unroll
                for (int m = 0; m < 4; ++m) {
                    const int row = row0 + ai * HALF + m * 16; const int pos = row & 4095;
                    const float* rp = rope + pos * 64 + 8 * fq;
                    const f32x4 c0 = *(const f32x4*)(rp), c1 = *(const f32x4*)(rp + 4), s0 = *(const f32x4*)(rp + 32), s1 = *(const f32x4*)(rp + 36);
                    const f32x4 x10 = acc[ai][0][m][0], x11 = acc[ai][0][m][1], x20 = acc[ai][1][m][0], x21 = acc[ai][1][m][1];
                    const f32x4 o10 = (x10 * c0 - x20 * s0) * sc, o11 = (x11 * c1 - x21 * s1) * sc;
                    const f32x4 o20 = (x20 * c0 + x10 * s0) * sc, o21 = (x21 * c1 + x11 * s1) * sc;
                    bf16_t* rowp = base + (size_t)row * 512 + hf * 256 + wc * 64 + 8 * fq;
                    *(u32x4*)(rowp) = pack8(o10, o11);
                    *(u32x4*)(rowp + 32) = pack8(o20, o21);
                }
        } else {
#pragma unroll
            for (int ai = 0; ai < 2; ++ai)
#pragma unroll
                for (int m = 0; m < 4; ++m) {
                    bf16_t* rowp = base + (size_t)(row0 + ai * HALF + m * 16) * 512 + hf * 256 + wc * 32 + 8 * fq;
#pragma unroll
                    for (int bj = 0; bj < 2; ++bj) *(u32x4*)(rowp + bj * HALF) = pack8(acc[ai][bj][m][0] * sc, acc[ai][bj][m][1] * sc);
                }
        }
    }
};

struct EpiRes {
    const float* X; bf16_t* O;
    __device__ __forceinline__ void operator()(const f32x4 (&acc)[2][2][4][2], const Unit& u, int wr, int wc, int fr, int fq) const {
        const int row0 = u.pm * BM + wr * 64 + fr, col0 = u.pn * BM + wc * 32 + 8 * fq;
#pragma unroll
        for (int ai = 0; ai < 2; ++ai)
#pragma unroll
            for (int m = 0; m < 4; ++m) {
                const size_t off = (size_t)(row0 + ai * HALF + m * 16) * 1024 + col0;
#pragma unroll
                for (int bj = 0; bj < 2; ++bj) {
                    const f32x4 xa = *(const f32x4*)(X + off + bj * HALF), xb = *(const f32x4*)(X + off + bj * HALF + 4);
                    *(u32x4*)(O + off + bj * HALF) = pack8(acc[ai][bj][m][0] + xa, acc[ai][bj][m][1] + xb);
                }
                if (m & 1) asm volatile("" ::: "memory");
            }
    }
};

struct EpiSwiglu {
    bf16_t* ACT; const int* list; const float* r2;
    __device__ __forceinline__ void operator()(const f32x4 (&acc)[2][2][4][2], const Unit& u, int wr, int wc, int fr, int fq) const {
        const int rt0 = wr * 64 + fr;
#pragma unroll
        for (int ai = 0; ai < 2; ++ai)
#pragma unroll
            for (int m = 0; m < 4; ++m) {
                const int rt = rt0 + ai * HALF + m * 16;
                int tok = 0; if (rt < u.nv) tok = list[u.e * 16384 + u.mt * 256 + rt]; tok &= 16383;
                const float r = r2[tok];
                f32x4 a[2];
#pragma unroll
                for (int n = 0; n < 2; ++n) {
                    const f32x4 hg = acc[ai][0][m][n] * r, hu = acc[ai][1][m][n] * r;
#pragma unroll
                    for (int i = 0; i < 4; ++i) { const float e = __builtin_amdgcn_exp2f(hg[i] * -1.4426950408889634f); a[n][i] = hg[i] * __builtin_amdgcn_rcpf(1.0f + e) * hu[i]; }
                }
                *(u32x4*)(ACT + (size_t)(u.pm * BM + rt) * 512 + u.pn * 128 + wc * 32 + 8 * fq) = pack8(a[0], a[1]);
            }
    }
};

struct EpiY {
    bf16_t* Y;
    __device__ __forceinline__ void operator()(const f32x4 (&acc)[2][2][4][2], const Unit& u, int wr, int wc, int fr, int fq) const {
        const int row0 = u.pm * BM + wr * 64 + fr, col0 = u.pn * BM + wc * 32 + 8 * fq;
#pragma unroll
        for (int ai = 0; ai < 2; ++ai)
#pragma unroll
            for (int m = 0; m < 4; ++m) {
                bf16_t* rowp = Y + (size_t)(row0 + ai * HALF + m * 16) * 1024 + col0;
#pragma unroll
                for (int bj = 0; bj < 2; ++bj) *(u32x4*)(rowp + bj * HALF) = pack8(acc[ai][bj][m][0], acc[ai][bj][m][1]);
            }
    }
};
}
namespace attn_body {
using bf16=__hip_bfloat16;
using bf16x8=__attribute__((ext_vector_type(8)))short;
using s16x4=__attribute__((ext_vector_type(4)))short;
using f32x16=__attribute__((ext_vector_type(16)))float;
using f32x4=__attribute__((ext_vector_type(4)))float;
using u32x4=__attribute__((ext_vector_type(4)))unsigned;
constexpr int SEQ=4096,D=64,DMI=512;
constexpr int NW=8,QBLK=32,QB=QBLK*NW,KVBLK=64,NQB=SEQ/QB;
__device__ __forceinline__ int crow(int r,int hi){return (r&3)+8*(r>>2)+4*hi;}
#define SBAR() __builtin_amdgcn_sched_barrier(0)
__device__ __forceinline__ void cmask(f32x16&p0,f32x16&p1,int jb,int qrel,int hi){
  const float NEG=-INFINITY; int kb=64*jb+4*hi;
  #pragma unroll
  for(int r=0;r<16;++r){int kv=kb+(r&3)+8*(r>>2); if(kv>qrel)p0[r]=NEG; if(kv+32>qrel)p1[r]=NEG;}
}
__device__ __forceinline__ void kmask(f32x16&p0,f32x16&p1,int jb,int wid){
  const float NEG=-INFINITY;
  if(jb>(wid>>1)){
    #pragma unroll
    for(int r=0;r<16;++r){p0[r]=NEG;p1[r]=NEG;}
  }
}

constexpr int NSLOT=3, SLOTB=8192;
constexpr int LDS_K=0, LDS_V=NSLOT*SLOTB, LDS_WS=2*NSLOT*SLOTB, LDS_OST=LDS_WS+NW*64*4, LDS_GL=LDS_OST+NW*4096, LDS_BYTES=LDS_GL+SEQ*4;
constexpr float C2=0.125f*1.4426950408889634f;
__device__ __forceinline__ void glds16(const void*gsrc,unsigned lds_dst){unsigned keep;
  asm volatile("s_mov_b32 %0, m0\n\ts_mov_b32 m0, %2\n\ts_nop 0\n\tglobal_load_lds_dwordx4 %1, off\n\ts_mov_b32 m0, %0":"=&s"(keep):"v"(gsrc),"s"(lds_dst):"memory");}
__device__ __forceinline__ float max3f(float a,float b,float c){float r;asm("v_max3_f32 %0, %1, %2, %3":"=v"(r):"v"(a),"v"(b),"v"(c));return r;}
__device__ __forceinline__ float max2f(float a,float b){float r;asm("v_max_f32_e32 %0, %1, %2":"=v"(r):"v"(a),"v"(b));return r;}
__device__ __forceinline__ float fsub_s(float a,float b){float r;asm("v_sub_f32_e32 %0, %1, %2":"=v"(r):"v"(a),"v"(b));return r;}
typedef float f32x2_t __attribute__((ext_vector_type(2))); typedef __bf16 bf16x2_t __attribute__((ext_vector_type(2)));
__device__ __forceinline__ unsigned cvtpk_s(float lo,float hi){f32x2_t v={lo,hi};bf16x2_t b=__builtin_convertvector(v,bf16x2_t);return __builtin_bit_cast(unsigned,b);}
__device__ __forceinline__ float bf_lo(unsigned w){return __uint_as_float(w<<16);} __device__ __forceinline__ float bf_hi(unsigned w){return __uint_as_float(w&0xffff0000u);}
#define WAIT_BAR(N) asm volatile("s_waitcnt vmcnt(" #N ") lgkmcnt(0)\n\ts_barrier":::"memory")

__device__ __forceinline__ void qkt(f32x16&p0,f32x16&p1,const char*Kslot,const bf16x8*qr,const f32x16&c0,const f32x16&c1,int r32,int hi){
  const char*kb=Kslot+hi*1024+r32*16;
  #pragma unroll
  for(int d0=0;d0<4;++d0){
    const bf16x8 b0=*reinterpret_cast<const bf16x8*>(kb+d0*2048);
    const bf16x8 b1=*reinterpret_cast<const bf16x8*>(kb+d0*2048+512);
    if(d0==0){p0=__builtin_amdgcn_mfma_f32_32x32x16_bf16(b0,qr[0],c0,0,0,0);p1=__builtin_amdgcn_mfma_f32_32x32x16_bf16(b1,qr[0],c1,0,0,0);}
    else{p0=__builtin_amdgcn_mfma_f32_32x32x16_bf16(b0,qr[d0],p0,0,0,0);p1=__builtin_amdgcn_mfma_f32_32x32x16_bf16(b1,qr[d0],p1,0,0,0);}}
}
typedef __attribute__((address_space(3))) const char* lds_cptr;
typedef short v4i16_t __attribute__((ext_vector_type(4)));
__device__ __forceinline__ void kload8(bf16x8*kf,lds_cptr kp){
  kf[0]=*(const __attribute__((address_space(3))) bf16x8*)(kp);      kf[1]=*(const __attribute__((address_space(3))) bf16x8*)(kp+512);
  kf[2]=*(const __attribute__((address_space(3))) bf16x8*)(kp+2048); kf[3]=*(const __attribute__((address_space(3))) bf16x8*)(kp+2560);
  kf[4]=*(const __attribute__((address_space(3))) bf16x8*)(kp+4096); kf[5]=*(const __attribute__((address_space(3))) bf16x8*)(kp+4608);
  kf[6]=*(const __attribute__((address_space(3))) bf16x8*)(kp+6144); kf[7]=*(const __attribute__((address_space(3))) bf16x8*)(kp+6656);
}
__device__ __forceinline__ void kload2(bf16x8*kf,lds_cptr kp,int j){ kf[2*j]=*(const __attribute__((address_space(3))) bf16x8*)(kp+j*2048); kf[2*j+1]=*(const __attribute__((address_space(3))) bf16x8*)(kp+j*2048+512); }
__device__ __forceinline__ s16x4 vtr(lds_cptr p){ return __builtin_bit_cast(s16x4,__builtin_amdgcn_ds_read_tr16_b64_v4i16((__attribute__((address_space(3))) v4i16_t*)p)); }
typedef __attribute__((address_space(3))) const float* lds_fptr;
__device__ __forceinline__ void bias_tuples(f32x16&c0,f32x16&c1,lds_fptr glt,int hi,float nmh){
  #pragma unroll
  for(int g=0;g<4;++g){
    const f32x4 a=*(const __attribute__((address_space(3))) f32x4*)(glt+8*g+4*hi);
    const f32x4 b=*(const __attribute__((address_space(3))) f32x4*)(glt+32+8*g+4*hi);
    #pragma unroll
    for(int i=0;i<4;++i){c0[4*g+i]=a[i]+nmh;c1[4*g+i]=b[i]+nmh;}
  }
}
__device__ __forceinline__ float rowmax(const f32x16&p0,const f32x16&p1){
  float a=max3f(p0[0],p0[1],p1[0]),b=max3f(p0[2],p0[3],p1[1]);a=max3f(a,p1[2],p1[3]);
  #pragma unroll
  for(int r=4;r<16;r+=4){a=max3f(a,p0[r],p0[r+1]);b=max3f(b,p0[r+2],p0[r+3]);a=max3f(a,p1[r],p1[r+1]);b=max3f(b,p1[r+2],p1[r+3]);}
  const float m=max2f(a,b);
  auto rr=__builtin_amdgcn_permlane32_swap(__float_as_uint(m),__float_as_uint(m),false,false);
  return max2f(__uint_as_float(rr[0]),__uint_as_float(rr[1]));
}
__device__ __forceinline__ void pv(f32x16*o,int vb,bf16x8 pa0,bf16x8 pa1,bf16x8 pa2,bf16x8 pa3){
  #pragma unroll
  for(int d0=0;d0<2;++d0){s16x4 lo[4],hi[4];
    #pragma unroll
    for(int ks=0;ks<4;++ks){
      asm volatile("ds_read_b64_tr_b16 %0,%1 offset:%c2":"=&v"(lo[ks]):"v"(vb),"i"(d0*4096+ks*1024):"memory");
      asm volatile("ds_read_b64_tr_b16 %0,%1 offset:%c2":"=&v"(hi[ks]):"v"(vb),"i"(d0*4096+ks*1024+512):"memory");}
    asm volatile("s_waitcnt lgkmcnt(0)":::"memory");SBAR();
    #define PK(k) (bf16x8){lo[k][0],lo[k][1],lo[k][2],lo[k][3],hi[k][0],hi[k][1],hi[k][2],hi[k][3]}
    o[d0]=__builtin_amdgcn_mfma_f32_32x32x16_bf16(pa0,PK(0),o[d0],0,0,0);
    o[d0]=__builtin_amdgcn_mfma_f32_32x32x16_bf16(pa1,PK(1),o[d0],0,0,0);
    o[d0]=__builtin_amdgcn_mfma_f32_32x32x16_bf16(pa2,PK(2),o[d0],0,0,0);
    o[d0]=__builtin_amdgcn_mfma_f32_32x32x16_bf16(pa3,PK(3),o[d0],0,0,0);
    #undef PK
  }
}

template<int MODE,int THRL> __device__ __forceinline__ void attn_unit(long rowbase,int qb,const bf16*Q,const bf16*__restrict__ K,const bf16*__restrict__ V,bf16*O,int opitch,const float*glp,float lam,float*ssp,char*shm){
  int tid_=threadIdx.x; asm volatile("":"+v"(tid_));
  const int tid=tid_,lane=tid&63,r32=lane&31,hi=lane>>5; const int wid=__builtin_amdgcn_readfirstlane(tid>>6);
  const int q0=qb*QB;
  const bf16*Qw=Q+(rowbase+q0+wid*QBLK)*DMI;
  const bf16*Kh=K+rowbase*DMI,*Vh=V+rowbase*DMI;
  const unsigned lds0=(unsigned)(uintptr_t)shm;
  float*wsf=(float*)(shm+LDS_WS)+wid*64;
  const int NT=(q0+QB)/KVBLK;
  const lds_cptr shm3=(lds_cptr)shm;
  const lds_fptr glt0=(lds_fptr)(shm3+LDS_GL);
  if constexpr(MODE==0){
    __attribute__((address_space(3))) f32x4* gd=(__attribute__((address_space(3))) f32x4*)(shm3+LDS_GL);
    const int n4=(q0+QB)>>2;
    for(int i=tid;i<n4;i+=NW*64){ const f32x4 v=*(const f32x4*)(glp+4*i); gd[i]=v; }
  }
  const bf16*ksrc=Kh+(long)lane*DMI+wid*8;
  const bf16*vsrc=Vh+(long)(16*(wid&3)+(lane>>2))*DMI+(wid>>2)*32+(lane&3)*8;
  const unsigned kdst=lds0+LDS_K+wid*1024, vdst=lds0+LDS_V+wid*1024;
  #define DMA_K(t,slot) glds16(ksrc+(long)(t)*KVBLK*DMI,(unsigned)__builtin_amdgcn_readfirstlane(kdst+(slot)))
  #define DMA_V(t,slot) glds16(vsrc+(long)(t)*KVBLK*DMI,(unsigned)__builtin_amdgcn_readfirstlane(vdst+(slot)))
  const int vb0=(int)(lds0+LDS_V)+((lane>>4)&1)*32+(lane&3)*8+(4*hi+((lane&15)>>2))*64;
  const char*Kbase=shm+LDS_K; bf16x8 kf[8];
  const lds_cptr kp0=shm3+LDS_K+hi*1024+r32*16; const lds_cptr vp0=shm3+LDS_V+((lane>>4)&1)*32+(lane&3)*8+(4*hi+((lane&15)>>2))*64;
  DMA_K(0,0);DMA_V(0,0);DMA_K(1,SLOTB);
  bf16x8 qr[4];
  #pragma unroll
  for(int d0=0;d0<4;++d0)qr[d0]=*reinterpret_cast<const bf16x8*>(&Qw[(long)r32*DMI+d0*16+hi*8]);
  float mhat=0.f,l_reg=0.f;f32x16 o[2];o[0]=f32x16{};o[1]=f32x16{};f32x16 negm=f32x16{};asm volatile("":"+v"(negm));
  float nmh=0.f;
  const int qrel=wid*QBLK+r32;
  #define CMASK(P0,P1,t) do{int jb_=(t)-(NT-4); if(jb_>=0){ if constexpr(MODE==0)cmask(P0,P1,jb_,qrel,hi); else kmask(P0,P1,jb_,wid);} }while(0)
  bool resc=false;
  #define SETREF() do{ if constexpr(MODE==0){ nmh=-mhat; } else { _Pragma("unroll") for(int r=0;r<16;++r)negm[r]=-mhat; asm volatile("":"+v"(negm)); } }while(0)
  #define START(P0,P1) do{ const float rm=rowmax(P0,P1); resc=false; \
    { const float dl=rm; mhat=mhat+dl; \
      _Pragma("unroll") for(int r=0;r<16;++r){P0[r]=fsub_s(P0[r],dl);P1[r]=fsub_s(P1[r],dl);} \
      SETREF(); } \
    _Pragma("unroll") for(int r=0;r<16;++r)P0[r]=__builtin_amdgcn_exp2f(P0[r]); }while(0)
  #define RESC() do{ if(resc){ asm volatile("s_waitcnt lgkmcnt(0)":::"memory"); \
      _Pragma("unroll") for(int d_=0;d_<2;++d_) _Pragma("unroll") for(int r=0;r<16;++r)o[d_][r]*=wsf[crow(r,hi)]; } }while(0)
  f32x16 pA0,pA1,pB0,pB1;
  int sl_prev=0,sl_cur=0,sl_next=SLOTB;
  #define ROT() do{sl_prev=sl_cur;sl_cur=sl_next;sl_next=(sl_next==(NSLOT-1)*SLOTB)?0:sl_next+SLOTB;}while(0)
  DMA_K(2,2*SLOTB);
  WAIT_BAR(3);
  if constexpr(MODE==0){ f32x16 c0,c1; bias_tuples(c0,c1,glt0,hi,0.f); qkt(pA0,pA1,Kbase,qr,c0,c1,r32,hi); }
  else qkt(pA0,pA1,Kbase,qr,negm,negm,r32,hi);
  asm volatile("s_nop 15\n\ts_nop 7":"+v"(pA0),"+v"(pA1));CMASK(pA0,pA1,0);
  START(pA0,pA1);
  _Pragma("unroll") for(int r=0;r<16;++r)pA1[r]=__builtin_amdgcn_exp2f(pA1[r]);
  WAIT_BAR(0);
  DMA_K(3,0);DMA_V(1,SLOTB);
  ROT();
  kload8(kf,kp0+sl_cur);
  WAIT_BAR(2);
  s16x4 vlo[8],vhi[8]; u32x4 pw0,pw1,pw2,pw3;
  #define PKW(P,B) cvtpk_s(P[B],P[B+1])
  #define PAF(k) __builtin_bit_cast(bf16x8,pw##k)
  #define VFR(i) (bf16x8){vlo[i][0],vlo[i][1],vlo[i][2],vlo[i][3],vhi[i][0],vhi[i][1],vhi[i][2],vhi[i][3]}
  #define PIN(x) asm volatile("":"+v"(x))
  #define MX3(a,b,c) __builtin_fmaxf(__builtin_fmaxf((a),(b)),(c))
  #define GAPA(MF,A0,A1,A2,A3,W0,W1,PW) do{ MF; sacc+=A0; sacc+=A1; sacc+=A2; sacc+=A3; PIN(sacc); W0; W1; PIN(PW); SBAR(); }while(0)
  #define EX(v) __builtin_amdgcn_exp2f(v)
  #define GAPB(MF,X,B) do{ MF; X[B]=EX(X[B]); X[B+1]=EX(X[B+1]); X[B+2]=EX(X[B+2]); X[B+3]=EX(X[B+3]); PIN(X); SBAR(); }while(0)
  #define VRD(i) do{ vlo[i]=vtr(vp_+(((i)>>2)*4096+((i)&3)*1024)); vhi[i]=vtr(vp_+(((i)>>2)*4096+((i)&3)*1024+512)); }while(0)
  #define KRD(G,j) do{ if(G){ kload2(kf,kp0+sl_next,j); SBAR(); } }while(0)
  #define STEP(C0,C1,P0,P1,t,GK,GV,GL) do{ SBAR(); \
    f32x16 ci0_,ci1_; if constexpr(MODE==0){ bias_tuples(ci0_,ci1_,glt0+64*(t),hi,nmh); } else { ci0_=negm; ci1_=negm; } \
    const lds_cptr vp_=vp0+sl_prev; \
    VRD(0); SBAR(); float sacc=(P0[0]+P0[1]); \
    GAPA(C0=__builtin_amdgcn_mfma_f32_32x32x16_bf16(kf[0],qr[0],ci0_,0,0,0), P0[2],P0[3],P0[4],P0[5],     pw0[0]=PKW(P0,0), pw0[1]=PKW(P0,2), pw0); \
    VRD(4); SBAR(); GAPA(C1=__builtin_amdgcn_mfma_f32_32x32x16_bf16(kf[1],qr[0],ci1_,0,0,0), P0[6],P0[7],P0[8],P0[9],     pw0[2]=PKW(P0,4), pw0[3]=PKW(P0,6), pw0); \
    VRD(1); SBAR(); GAPA(C0=__builtin_amdgcn_mfma_f32_32x32x16_bf16(kf[2],qr[1],C0,0,0,0),   P0[10],P0[11],P0[12],P0[13], pw1[0]=PKW(P0,8), pw1[1]=PKW(P0,10), pw1); \
    VRD(5); SBAR(); GAPA(C1=__builtin_amdgcn_mfma_f32_32x32x16_bf16(kf[3],qr[1],C1,0,0,0),   P0[14],P0[15],P1[0],P1[1],   pw1[2]=PKW(P0,12),pw1[3]=PKW(P0,14), pw1); \
    VRD(2); SBAR(); GAPA(C0=__builtin_amdgcn_mfma_f32_32x32x16_bf16(kf[4],qr[2],C0,0,0,0),   P1[2],P1[3],P1[4],P1[5],     pw2[0]=PKW(P1,0), pw2[1]=PKW(P1,2), pw2); \
    VRD(6); SBAR(); GAPA(C1=__builtin_amdgcn_mfma_f32_32x32x16_bf16(kf[5],qr[2],C1,0,0,0),   P1[6],P1[7],P1[8],P1[9],     pw2[2]=PKW(P1,4), pw2[3]=PKW(P1,6), pw2); \
    VRD(3); SBAR(); GAPA(C0=__builtin_amdgcn_mfma_f32_32x32x16_bf16(kf[6],qr[3],C0,0,0,0),   P1[10],P1[11],P1[12],P1[13], pw3[0]=PKW(P1,8), pw3[1]=PKW(P1,10), pw3); \
    VRD(7); SBAR(); GAPA(C1=__builtin_amdgcn_mfma_f32_32x32x16_bf16(kf[7],qr[3],C1,0,0,0),   P1[14],P1[15],0.f,0.f,       pw3[2]=PKW(P1,12),pw3[3]=PKW(P1,14), pw3); \
    l_reg+=sacc; \
    if(GK){DMA_K((t)+3,sl_cur);} if(GV){DMA_V((t)+1,sl_next);} \
    CMASK(C0,C1,t); \
    { float a=MX3(C0[0],C0[1],C1[0]),b=MX3(C0[2],C0[3],C1[1]); a=MX3(a,C1[2],C1[3]); \
      _Pragma("unroll") for(int r=4;r<16;r+=4){a=MX3(a,C0[r],C0[r+1]);b=MX3(b,C0[r+2],C0[r+3]);a=MX3(a,C1[r],C1[r+1]);b=MX3(b,C1[r+2],C1[r+3]);} \
      float rm=__builtin_fmaxf(a,b); { auto rr=__builtin_amdgcn_permlane32_swap(__float_as_uint(rm),__float_as_uint(rm),false,false); rm=__builtin_fmaxf(__uint_as_float(rr[0]),__uint_as_float(rr[1])); } \
      resc=false; \
      if(__builtin_expect(__any(rm>(float)THRL),0)){ const float dl=__builtin_fmaxf(rm,0.f); mhat+=dl; \
        _Pragma("unroll") for(int r=0;r<16;++r){C0[r]-=dl;C1[r]-=dl;} \
        SETREF(); \
        const float f=__builtin_amdgcn_exp2f(-dl); l_reg*=f; if(hi==0)wsf[r32]=f; resc=true; } } \
    SBAR(); \
    GAPB(o[0]=__builtin_amdgcn_mfma_f32_32x32x16_bf16(PAF(0),VFR(0),o[0],0,0,0), C0,0); \
    GAPB(o[1]=__builtin_amdgcn_mfma_f32_32x32x16_bf16(PAF(0),VFR(4),o[1],0,0,0), C0,4); \
    KRD(GL,0); GAPB(o[0]=__builtin_amdgcn_mfma_f32_32x32x16_bf16(PAF(1),VFR(1),o[0],0,0,0), C0,8); \
    KRD(GL,1); GAPB(o[1]=__builtin_amdgcn_mfma_f32_32x32x16_bf16(PAF(1),VFR(5),o[1],0,0,0), C0,12); \
    KRD(GL,2); GAPB(o[0]=__builtin_amdgcn_mfma_f32_32x32x16_bf16(PAF(2),VFR(2),o[0],0,0,0), C1,0); \
    KRD(GL,3); GAPB(o[1]=__builtin_amdgcn_mfma_f32_32x32x16_bf16(PAF(2),VFR(6),o[1],0,0,0), C1,4); \
    GAPB(o[0]=__builtin_amdgcn_mfma_f32_32x32x16_bf16(PAF(3),VFR(3),o[0],0,0,0), C1,8); \
    GAPB(o[1]=__builtin_amdgcn_mfma_f32_32x32x16_bf16(PAF(3),VFR(7),o[1],0,0,0), C1,12); \
    }while(0)
  int t=1;
  #undef CMASK
  #define CMASK(P0,P1,t) do{}while(0)
  for(;t+5<NT;t+=2){
    STEP(pB0,pB1,pA0,pA1,t,true,true,true);     WAIT_BAR(2); RESC(); ROT();
    STEP(pA0,pA1,pB0,pB1,t+1,true,true,true);   WAIT_BAR(2); RESC(); ROT();
  }
  #undef CMASK
  #define CMASK(P0,P1,t) do{int jb_=(t)-(NT-4); if(jb_>=0){ if constexpr(MODE==0)cmask(P0,P1,jb_,qrel,hi); else kmask(P0,P1,jb_,wid);} }while(0)
  #define ENDW(tt) do{ if((tt)+3<NT){WAIT_BAR(2);} else if((tt)+2<NT){WAIT_BAR(1);} else {WAIT_BAR(0);} }while(0)
  for(;t+1<NT;t+=2){
    STEP(pB0,pB1,pA0,pA1,t,(t+3<NT),(t+1<NT),(t+1<NT));       ENDW(t);   RESC(); ROT();
    STEP(pA0,pA1,pB0,pB1,t+1,(t+4<NT),(t+2<NT),(t+2<NT));     ENDW(t+1); RESC(); ROT();
  }
  STEP(pB0,pB1,pA0,pA1,NT-1,false,false,false); RESC();
  { float sacc=pB0[0]+pB0[1]; _Pragma("unroll") for(int r=2;r<16;++r)sacc+=pB0[r]; _Pragma("unroll") for(int r=0;r<16;++r)sacc+=pB1[r]; l_reg+=sacc;
    pw0=(u32x4){PKW(pB0,0),PKW(pB0,2),PKW(pB0,4),PKW(pB0,6)};pw1=(u32x4){PKW(pB0,8),PKW(pB0,10),PKW(pB0,12),PKW(pB0,14)};pw2=(u32x4){PKW(pB1,0),PKW(pB1,2),PKW(pB1,4),PKW(pB1,6)};pw3=(u32x4){PKW(pB1,8),PKW(pB1,10),PKW(pB1,12),PKW(pB1,14)};
    SBAR(); pv(o,vb0+sl_cur,PAF(0),PAF(1),PAF(2),PAF(3)); }
  #undef PKW
  #undef PAF
  #undef VFR
  #undef PIN
  #undef MX3
  #undef GAPA
  #undef GAPB
  #undef EX
  #undef VRD
  #undef KRD
  #undef STEP
  #undef ENDW
  {auto rr=__builtin_amdgcn_permlane32_swap(__float_as_uint(l_reg),__float_as_uint(l_reg),false,false);l_reg=__uint_as_float(rr[0])+__uint_as_float(rr[1]);}
  if(hi==0)wsf[32+r32]=l_reg;asm volatile("s_waitcnt lgkmcnt(0)":::"memory");
  float rli[16];
  #pragma unroll
  for(int r=0;r<16;++r)rli[r]=__builtin_amdgcn_rcpf(wsf[32+crow(r,hi)]);
  bf16*Ow=O+(rowbase+q0+wid*QBLK)*(long)opitch;
  { bf16*stg=(bf16*)(shm+LDS_OST)+wid*2048;
    #pragma unroll
    for(int r=0;r<16;++r){const int orow=crow(r,hi);
      #pragma unroll
      for(int d0=0;d0<2;++d0){
        float val=o[d0][r]*rli[r];
        if constexpr(MODE==2){ val=__bfloat162float(stg[orow*64+d0*32+r32])-lam*val; }
        stg[orow*64+d0*32+r32]=__float2bfloat16(val);}}
    asm volatile("s_waitcnt lgkmcnt(0)":::"memory");
    if constexpr(MODE!=1){
      #pragma unroll
      for(int i=0;i<4;++i){const int row=i*8+(lane>>3),ch=lane&7; const u32x4 v=*(const u32x4*)(stg+row*64+ch*8);
        if constexpr(MODE==2){
          float s=0.f;
          #pragma unroll
          for(int j=0;j<4;++j){const float a=bf_lo(v[j]),b=bf_hi(v[j]); s+=a*a+b*b;}
          s+=__shfl_xor(s,1); s+=__shfl_xor(s,2); s+=__shfl_xor(s,4);
          if(ch==0)ssp[(rowbase+q0+wid*QBLK+row)*8]=s;
        }
        *(u32x4*)(Ow+(long)row*opitch+ch*8)=v;} }
  }
  asm volatile("s_waitcnt lgkmcnt(0)\n\ts_barrier":::"memory");
  #undef DMA_K
  #undef DMA_V
  #undef CMASK
  #undef START
  #undef SETREF
  #undef RESC
  #undef ROT
}
#undef SBAR
#undef WAIT_BAR
}
#ifndef REPMASK
#define REPMASK 0
#endif
#define REPS(k) (((REPMASK) >> (k)) & 1 ? 2 : 1)
#ifndef AMM
#define AMM 3
#endif
#ifndef PHM
#define PHM 1023
#endif
constexpr int NWAVES = 8;
constexpr int BATCH = 4, SEQ = 4096, DM = 1024, M = BATCH * SEQ;
constexpr int DIN = 3080, NPROJ = 3072, NEXP = 16, DEXP = 512, LISTCAP = 16384;
constexpr float EPS = 1e-6f, LOG2E = 1.4426950408889634f;
constexpr float LAM_INIT = 0.2f;

constexpr size_t MiB = 1u << 20;
constexpr size_t WS_CTL = 0, CTL_ZERO_BYTES = 1 * MiB;
constexpr size_t WS_GL = 1 * MiB;
constexpr size_t WS_FLOG = WS_GL + 512 * 1024;
constexpr size_t WS_ROPE = 2 * MiB;
constexpr size_t WS_WR = 3 * MiB;
constexpr size_t WS_SS = 3 * MiB + 256 * 1024;
constexpr size_t WS_WIN = 4 * MiB, WS_WOUT = 10 * MiB, WS_WGU = 12 * MiB, WS_WD = 44 * MiB;
constexpr size_t WS_XN = 60 * MiB;
constexpr size_t WS_DD = 60 * MiB;
constexpr size_t WS_LIST = 76 * MiB;
constexpr size_t WS_TOKI = 77 * MiB;
constexpr size_t WS_TOKW = 77 * MiB + 256 * 1024;
constexpr size_t WS_R2 = 77 * MiB + 384 * 1024;
constexpr size_t WS_QKV = 92 * MiB, QKV_STRIDE = 16 * MiB;
constexpr size_t WS_ACT = 92 * MiB;
constexpr size_t WS_Y = 128 * MiB;
constexpr size_t WS_OA = 188 * MiB;
constexpr size_t WS_X1B = 220 * MiB;
constexpr size_t WS_END = 252 * MiB;
constexpr int CW_TMO = 0, CW_CODE = 1, CW_BAR = 4096, CW_CNT = 8192;
constexpr int RING_OFF = 0, RING_BYTES = 131072;
constexpr int LDSCTL_OFF = RING_BYTES, MISC_OFF = LDSCTL_OFF + 320;
constexpr int LDS_BYTES = 147456;
static_assert(MISC_OFF + 128 <= LDS_BYTES, "LDS map");
static_assert(attn_body::LDS_BYTES <= RING_BYTES, "attention scratch fits the ring region");

#define GAS __attribute__((address_space(1)))
#define LAS __attribute__((address_space(3)))
typedef unsigned short bf16;
typedef unsigned v4u __attribute__((ext_vector_type(4)));
typedef float f32x4 __attribute__((ext_vector_type(4)));
typedef GAS unsigned gu32;
#define RLX_AGENT __ATOMIC_RELAXED, __HIP_MEMORY_SCOPE_AGENT
#define LDS_WAIT() asm volatile("s_waitcnt lgkmcnt(0)" ::: "memory")
#define VM_WAIT() asm volatile("s_waitcnt vmcnt(0)" ::: "memory")
__device__ __forceinline__ unsigned f2bf(float f) { unsigned u = __builtin_bit_cast(unsigned, f); return (u + 0x7fffu + ((u >> 16) & 1u)) >> 16; }
__device__ __forceinline__ unsigned pk2(float lo, float hi) { return f2bf(lo) | (f2bf(hi) << 16); }
__device__ __forceinline__ float bflo(unsigned w) { return __uint_as_float(w << 16); }
__device__ __forceinline__ float bfhi(unsigned w) { return __uint_as_float(w & 0xffff0000u); }

#define XB_TMO      128
#define XB_XCNT(j)  (256  + 64 * (j))
#define XB_XSUB(j)  (1280 + 64 * (j))
#define XB_XGEN(j)  (2304 + 64 * (j))
#define XB_TOP      3328
#define XB_TOPGEN   3392
#define XCD_BAR_WORDS 3456
#define XB_SPIN_CAP (1u << 18)
__device__ __forceinline__ unsigned xb_ld(unsigned* p)              { return __hip_atomic_load(p, __ATOMIC_RELAXED, __HIP_MEMORY_SCOPE_AGENT); }
__device__ __forceinline__ unsigned xb_add(unsigned* p, unsigned v) { return __hip_atomic_fetch_add(p, v, __ATOMIC_RELAXED, __HIP_MEMORY_SCOPE_AGENT); }
__device__ __forceinline__ unsigned xb_xcc_id() { return (unsigned)__builtin_amdgcn_s_getreg((3 << 11) | 20) & 0xFu; }
#define XB_SPIN(cond, bar) do { unsigned _sp = 0; while (cond) { __builtin_amdgcn_s_sleep(1); \
    if ((++_sp & 255u) == 0u) { if (xb_ld(&(bar)[XB_TMO])) break; if (_sp > XB_SPIN_CAP) { atomicAdd(&(bar)[XB_TMO], 1u); break; } } } } while (0)
struct XcdBarrier { unsigned* bar; unsigned x; volatile LAS unsigned* st; };
__device__ __forceinline__ XcdBarrier xcd_barrier_post(unsigned* bar, volatile LAS unsigned* st) {
    XcdBarrier b; b.bar = bar; b.x = xb_xcc_id(); b.st = st;
    if (threadIdx.x == 0) (void)xb_add(&bar[XB_XCNT(b.x)], 1u);
    return b;
}
__device__ __forceinline__ void xcd_barrier_complete(unsigned* bar, unsigned x, unsigned& nloc, unsigned& nx) {
    const unsigned G = gridDim.x * gridDim.y * gridDim.z;
    unsigned sum, cnt, mine, sp = 0u;
    for (;;) {
        sum = 0u; cnt = 0u; mine = 0u;
#pragma unroll
        for (unsigned j = 0; j < 16; ++j) { const unsigned c = xb_ld(&bar[XB_XCNT(j)]); sum += c; cnt += (c > 0u) ? 1u : 0u; mine = (j == x) ? c : mine; }
        if (sum == G) break;
        __builtin_amdgcn_s_sleep(1);
        if ((++sp & 255u) == 0u) { if (xb_ld(&bar[XB_TMO])) break; if (sp > XB_SPIN_CAP) { atomicAdd(&bar[XB_TMO], 1u); break; } }
    }
    nloc = mine > 0u ? mine : 1u; nx = cnt > 0u ? cnt : 1u;
}
__device__ __forceinline__ void xcd_barrier(const XcdBarrier& b) {
    asm volatile("s_waitcnt vmcnt(0)" ::: "memory");
    __syncthreads();
    if (threadIdx.x == 0) {
        unsigned* bar = b.bar;
        __builtin_amdgcn_s_waitcnt(0);
        unsigned nloc = b.st[0], nx = b.st[1];
        if (nloc == 0u) { xcd_barrier_complete(bar, b.x, nloc, nx); b.st[0] = nloc; b.st[1] = nx; }
        const unsigned old = xb_add(&bar[XB_XSUB(b.x)], 1u);
        const unsigned gen = old / nloc;
        if (old + 1u == (gen + 1u) * nloc) {
            __builtin_amdgcn_fence(__ATOMIC_RELEASE, "agent");
            asm volatile("s_waitcnt vmcnt(0)" ::: "memory");
            const unsigned og = xb_add(&bar[XB_TOP], 1u);
            const unsigned tg = og / nx;
            if (og + 1u == (tg + 1u) * nx) xb_add(&bar[XB_TOPGEN], 1u);
            else XB_SPIN(xb_ld(&bar[XB_TOPGEN]) == tg, bar);
            __builtin_amdgcn_fence(__ATOMIC_ACQUIRE, "agent");
            xb_add(&bar[XB_XGEN(b.x)], 1u);
            asm volatile("s_waitcnt vmcnt(0)" ::: "memory");
        } else {
            XB_SPIN(xb_ld(&bar[XB_XGEN(b.x)]) == gen, bar);
            __builtin_amdgcn_fence(__ATOMIC_ACQUIRE, "agent");
            asm volatile("s_waitcnt vmcnt(0)" ::: "memory");
        }
    }
    __syncthreads();
}

struct Args { const float* in[19]; float* out; unsigned char* ws; };

struct Frame {
    LAS unsigned char* lds; volatile LAS unsigned* MISC; gu32* ctl;
    int tid, lane, wave, vcu, G;
};

__device__ __forceinline__ float wave_sum(float v) {
#pragma unroll
    for (int o = 1; o < 64; o <<= 1) v += __shfl_xor(v, o);
    return v;
}

template <int CTRL> __device__ __forceinline__ float dppf(float v) { return __builtin_bit_cast(float, __builtin_amdgcn_update_dpp(0, __builtin_bit_cast(int, v), CTRL, 0xf, 0xf, false)); }
__device__ __forceinline__ float wave_sum_fast(float v) {
    v += dppf<0xB1>(v); v += dppf<0x4E>(v); v += dppf<0x124>(v); v += dppf<0x128>(v);
    v += __shfl_xor(v, 16);
    auto rr = __builtin_amdgcn_permlane32_swap(__float_as_uint(v), __float_as_uint(v), false, false);
    return __uint_as_float(rr[0]) + __uint_as_float(rr[1]);
}

struct TrItem { const float* src; const float* gk; bf16* dst; int ldw, K; };
__device__ __forceinline__ TrItem tr_decode(int it, const Args& a, int lane) {
    constexpr int I_IN = 16 * 96, I_OUT = 16 * 32, I_GU = 16 * 2 * 16 * 16;
    unsigned char* ws = a.ws; TrItem t; int r = it; int n0s, k0, dn0; const float* W;
    if (r < I_IN) { const int kb = r / 96, nb = r % 96;
        if (nb < 32) { const int U = nb >> 1, hf = nb & 1; dn0 = (U >> 2) * 256 + hf * 128 + 32 * (U & 3); } else dn0 = 32 * nb;
        W = a.in[2]; t.ldw = DIN; n0s = 32 * nb; k0 = 64 * kb; t.gk = a.in[1] + k0; t.K = DM; t.dst = (bf16*)(ws + WS_WIN) + (size_t)dn0 * DM + k0; }
    else if ((r -= I_IN) < I_OUT) { const int kb = r / 32, nb = r % 32;
        W = a.in[9]; t.ldw = DM; n0s = 32 * nb; k0 = 64 * kb; t.gk = nullptr; t.K = DM; t.dst = (bf16*)(ws + WS_WOUT) + (size_t)(32 * nb) * DM + k0; }
    else if ((r -= I_OUT) < I_GU) { const int e = r / 512, q = r % 512, up = q / 256, q2 = q % 256, kb = q2 / 16, nb = q2 % 16;
        W = (up ? a.in[16] : a.in[15]) + (size_t)e * DM * DEXP; t.ldw = DEXP; n0s = 32 * nb; k0 = 64 * kb; t.gk = a.in[10] + k0; t.K = DM;
        dn0 = e * 1024 + (nb >> 2) * 256 + up * 128 + (nb & 3) * 32; t.dst = (bf16*)(ws + WS_WGU) + (size_t)dn0 * DM + k0; }
    else { r -= I_GU; const int e = r / 256, q = r % 256, kb = q / 32, nb = q % 32;
        W = a.in[17] + (size_t)e * DEXP * DM; t.ldw = DM; n0s = 32 * nb; k0 = 64 * kb; t.gk = nullptr; t.K = DEXP; t.dst = (bf16*)(ws + WS_WD) + (size_t)(e * 1024 + 32 * nb) * DEXP + k0; }
    t.src = W + (size_t)(k0 + (lane >> 5)) * t.ldw + n0s + (lane & 31);
    return t;
}
__device__ __forceinline__ unsigned cvtpk_hw(float lo, float hi) { typedef float f2_t __attribute__((ext_vector_type(2))); typedef __bf16 b2_t __attribute__((ext_vector_type(2))); f2_t v = {lo, hi}; b2_t b = __builtin_convertvector(v, b2_t); return __builtin_bit_cast(unsigned, b); }

__device__ __forceinline__ void p0_prologue(Frame& F, const Args& a) {
    unsigned char* ws = a.ws;
    const float* x = a.in[0]; const float* g_attn = a.in[1]; const float* w_in = a.in[2]; const float* b_forget = a.in[3];
    const float* g_ffn = a.in[10]; const float* wr_g = a.in[11]; const float* wr_e = a.in[13];
    const int gw = F.vcu * NWAVES + F.wave, NGW = F.G * NWAVES, lane = F.lane;
    LAS float* wfL = (LAS float*)(F.lds + RING_OFF + 8 * 8704);
    for (int k = F.tid; k < DM; k += NWAVES * 64) { const float gk = g_attn[k]; const float* wp = w_in + (size_t)k * DIN + NPROJ;
        const f32x4 u0 = *(const f32x4*)(wp) * gk, u1 = *(const f32x4*)(wp + 4) * gk; *(LAS f32x4*)(wfL + 8 * k) = u0; *(LAS f32x4*)(wfL + 8 * k + 4) = u1; }
    LDS_WAIT(); __syncthreads();
    {
        f32x4 wf[16][2];
#pragma unroll
        for (int jj = 0; jj < 4; ++jj)
#pragma unroll
            for (int c = 0; c < 4; ++c) { const LAS float* p = wfL + 8 * (4 * lane + c + 256 * jj); wf[jj * 4 + c][0] = *(const LAS f32x4*)p; wf[jj * 4 + c][1] = *(const LAS f32x4*)(p + 4); }
        bf16* XN = (bf16*)(ws + WS_XN); float* FLOG = (float*)(ws + WS_FLOG);
        const float bfg = b_forget[lane & 7];
        f32x4 v[4], vn[4];
        if (gw < M) { const GAS f32x4* xr = (const GAS f32x4*)(x + (size_t)gw * DM) + lane;
#pragma unroll
            for (int j = 0; j < 4; ++j) vn[j] = xr[64 * j]; }
        for (int m = gw; m < M; m += NGW) {
#pragma unroll
            for (int j = 0; j < 4; ++j) v[j] = vn[j];
            if (m + NGW < M) { const GAS f32x4* xr = (const GAS f32x4*)(x + (size_t)(m + NGW) * DM) + lane;
#pragma unroll
                for (int j = 0; j < 4; ++j) vn[j] = xr[64 * j]; }
            float s2 = 0.f;
#pragma unroll
            for (int j = 0; j < 4; ++j) s2 += (v[j].x * v[j].x + v[j].y * v[j].y) + (v[j].z * v[j].z + v[j].w * v[j].w);
            const float rstd = 1.0f / sqrtf(wave_sum_fast(s2) * (1.f / DM) + EPS);
            f32x4 d0 = (f32x4){0.f, 0.f, 0.f, 0.f}, d1 = d0;
#pragma unroll
            for (int j = 0; j < 4; ++j)
#pragma unroll
                for (int c = 0; c < 4; ++c) { d0 += wf[j * 4 + c][0] * v[j][c]; d1 += wf[j * 4 + c][1] * v[j][c]; }
            float fl = 0.f;
#pragma unroll
            for (int q = 0; q < 4; ++q) { const float a0 = wave_sum_fast(d0[q]), a1 = wave_sum_fast(d1[q]); if (lane == q) fl = a0; if (lane == 4 + q) fl = a1; }
            if (lane < 8) { const float z = fl * rstd + bfg; const float az = fabsf(z);
                const float lf = fminf(z, 0.f) - log1pf(expf(-az));
                const int b = m >> 12, t = m & 4095; FLOG[(b * 8 + lane) * 4096 + t] = lf; }
            GAS unsigned long long* o8 = (GAS unsigned long long*)(XN + (size_t)m * DM) + lane;
#pragma unroll
            for (int j = 0; j < 4; ++j) o8[64 * j] = (unsigned long long)cvtpk_hw(v[j].x * rstd, v[j].y * rstd) | ((unsigned long long)cvtpk_hw(v[j].z * rstd, v[j].w * rstd) << 32);
        }
    }
    {
        const int gt = F.vcu * (NWAVES * 64) + F.tid, NGT = F.G * NWAVES * 64;
        float* rope = (float*)(ws + WS_ROPE);
        for (int i = gt; i < 4096 * 32; i += NGT) { const int pos = i >> 5, j = i & 31;
            const float inv = 1.0f / powf(10000.0f, (float)(2 * j) / 64.0f); const float ang = (float)pos * inv;
            float s, c; sincosf(ang, &s, &c); rope[pos * 64 + j] = c; rope[pos * 64 + 32 + j] = s; }
        bf16* WRH = (bf16*)(ws + WS_WR); bf16* WRL = WRH + 32 * 1024;
        for (int i = gt; i < 32 * 1024; i += NGT) { const int j = i >> 10, k = i & 1023; float v = 0.f;
            if (j < 4) v = wr_g[k * 4 + j] * g_ffn[k]; else if (j < 20) v = wr_e[k * 16 + (j - 4)] * g_ffn[k];
            const unsigned hi = f2bf(v); const float rem = v - __uint_as_float(hi << 16);
            WRH[i] = (bf16)hi; WRL[i] = (bf16)f2bf(rem); }
    }
    {
        constexpr int NITEMS = 16 * 96 + 16 * 32 + 16 * 2 * 16 * 16 + 16 * 8 * 32;
        LAS float* scr = (LAS float*)(F.lds + RING_OFF + F.wave * 8704);
        float bufv[32]; TrItem cur, nx;
        int it = gw;
        if (it < NITEMS) { cur = tr_decode(it, a, lane);
#pragma unroll
            for (int i = 0; i < 32; ++i) bufv[i] = cur.src[(size_t)(2 * i) * cur.ldw]; }
        while (it < NITEMS) {
            const int nit = it + NGW;
#pragma unroll
            for (int i = 0; i < 32; ++i) scr[(2 * i + (lane >> 5)) * 33 + (lane & 31)] = bufv[i];
            const int c = lane & 7;
            f32x4 g0 = (f32x4){1.f, 1.f, 1.f, 1.f}, g1 = g0;
            if (cur.gk) { g0 = *(const f32x4*)(cur.gk + 8 * c); g1 = *(const f32x4*)(cur.gk + 8 * c + 4); }
            if (nit < NITEMS) { nx = tr_decode(nit, a, lane);
#pragma unroll
                for (int i = 0; i < 32; ++i) bufv[i] = nx.src[(size_t)(2 * i) * nx.ldw]; }
            LDS_WAIT(); asm volatile("" ::: "memory");
#pragma unroll
            for (int j = 0; j < 4; ++j) { const int n = (lane >> 3) + 8 * j; const LAS float* s = scr + (8 * c) * 33 + n;
                v4u o; o.x = cvtpk_hw(s[0 * 33] * g0.x, s[1 * 33] * g0.y); o.y = cvtpk_hw(s[2 * 33] * g0.z, s[3 * 33] * g0.w);
                o.z = cvtpk_hw(s[4 * 33] * g1.x, s[5 * 33] * g1.y); o.w = cvtpk_hw(s[6 * 33] * g1.z, s[7 * 33] * g1.w);
                *(GAS v4u*)(cur.dst + (size_t)n * cur.K + 8 * c) = o; }
            LDS_WAIT(); asm volatile("" ::: "memory");
            cur = nx; it = nit;
        }
    }
}

__device__ __forceinline__ void p1_scan(Frame& F, const Args& a) {
    const float* FLOG = (const float*)(a.ws + WS_FLOG); float* GLo = (float*)(a.ws + WS_GL);
    LAS float* wsum = (LAS float*)(F.lds + RING_OFF);
    for (int bh = blockIdx.x; bh < 32; bh += F.G) {
        const f32x4* src = (const f32x4*)(FLOG + bh * 4096 + F.tid * 8);
        f32x4 u0 = src[0], u1 = src[1];
        float p[8]; p[0] = u0.x; p[1] = p[0] + u0.y; p[2] = p[1] + u0.z; p[3] = p[2] + u0.w; p[4] = p[3] + u1.x; p[5] = p[4] + u1.y; p[6] = p[5] + u1.z; p[7] = p[6] + u1.w;
        float incl = p[7];
#pragma unroll
        for (int o = 1; o < 64; o <<= 1) { const float nb = __shfl_up(incl, o); if (F.lane >= o) incl += nb; }
        if (F.lane == 63) wsum[F.wave] = incl;
        LDS_WAIT(); __syncthreads();
        float base = incl - p[7];
        for (int w = 0; w < F.wave; ++w) base += wsum[w];
        f32x4 o0, o1; o0.x = -LOG2E * (base + p[0]); o0.y = -LOG2E * (base + p[1]); o0.z = -LOG2E * (base + p[2]); o0.w = -LOG2E * (base + p[3]);
        o1.x = -LOG2E * (base + p[4]); o1.y = -LOG2E * (base + p[5]); o1.z = -LOG2E * (base + p[6]); o1.w = -LOG2E * (base + p[7]);
        f32x4* dst = (f32x4*)(GLo + bh * 4096 + F.tid * 8); dst[0] = o0; dst[1] = o1;
        LDS_WAIT(); __syncthreads();
    }
    VM_WAIT(); __syncthreads();
}

__device__ __forceinline__ void p25_diffnorm(Frame& F, const Args& a) {
    const bf16* DD = (const bf16*)(a.ws + WS_DD); const float* SS = (const float*)(a.ws + WS_SS); bf16* OA = (bf16*)(a.ws + WS_OA); const float* gd = a.in[8];
    const int gt = F.vcu * (NWAVES * 64) + F.tid, NGT = F.G * NWAVES * 64;
    for (int i = gt; i < M * 64; i += NGT) {
        const int tok = i >> 6, ch = i & 63, h = ch >> 4;
        const v4u d = *(const v4u*)(DD + (size_t)tok * 512 + 8 * ch);
        const float ss = SS[tok * 8 + 2 * h] + SS[tok * 8 + 2 * h + 1];
        const float s = (1.0f - LAM_INIT) / sqrtf(ss * (1.f / 128.f) + EPS);
        const float* gp = gd + ((8 * ch) & 127);
        const f32x4 g0 = *(const f32x4*)gp, g1 = *(const f32x4*)(gp + 4);
        v4u o; o.x = pk2(bflo(d.x) * s * g0.x, bfhi(d.x) * s * g0.y); o.y = pk2(bflo(d.y) * s * g0.z, bfhi(d.y) * s * g0.w);
        o.z = pk2(bflo(d.z) * s * g1.x, bfhi(d.z) * s * g1.y); o.w = pk2(bflo(d.w) * s * g1.z, bfhi(d.w) * s * g1.w);
        *(v4u*)(OA + (size_t)tok * 1024 + 8 * ch) = o;
    }
}

__device__ __forceinline__ void p35_route(Frame& F, const Args& a) {
    typedef short bf16x8_t __attribute__((ext_vector_type(8)));
    const bf16* X1B = (const bf16*)(a.ws + WS_X1B); const bf16* WRH = (const bf16*)(a.ws + WS_WR); const bf16* WRL = WRH + 32 * 1024;
    const float* bg = a.in[12]; const float* be = a.in[14];
    int* LIST = (int*)(a.ws + WS_LIST); int* TOKI = (int*)(a.ws + WS_TOKI); float* TOKW = (float*)(a.ws + WS_TOKW); float* R2 = (float*)(a.ws + WS_R2);
    LAS float* T = (LAS float*)(F.lds + RING_OFF);
    LAS int* lcnt = (LAS int*)(F.lds + RING_OFF + 2 * 64 * 36 * 4);
    const int lane = F.lane, tg = F.wave & 3, kh = F.wave >> 2, fr = lane & 15, fq = lane >> 4;
    for (int tb = F.vcu; tb < M / 64; tb += F.G) {
        const bf16* xr = X1B + (size_t)(tb * 64 + tg * 16 + fr) * DM + kh * 512 + 8 * fq;
        const bf16* wh = WRH + (size_t)fr * DM + kh * 512 + 8 * fq; const bf16* wl = WRL + (size_t)fr * DM + kh * 512 + 8 * fq;
        f32x4 acc0 = (f32x4){0.f, 0.f, 0.f, 0.f}, acc1 = acc0; float ss = 0.f;
#pragma unroll 4
        for (int s = 0; s < 16; ++s) {
            const v4u xa = *(const v4u*)(xr + 32 * s);
            const bf16x8_t h0 = *(const bf16x8_t*)(wh + 32 * s), h1 = *(const bf16x8_t*)(wh + 16 * DM + 32 * s), l0 = *(const bf16x8_t*)(wl + 32 * s), l1 = *(const bf16x8_t*)(wl + 16 * DM + 32 * s);
#pragma unroll
            for (int q = 0; q < 4; ++q) { const float u = bflo(xa[q]), v = bfhi(xa[q]); ss += u * u + v * v; }
            const bf16x8_t av = __builtin_bit_cast(bf16x8_t, xa);
            acc0 = __builtin_amdgcn_mfma_f32_16x16x32_bf16(av, h0, acc0, 0, 0, 0); acc0 = __builtin_amdgcn_mfma_f32_16x16x32_bf16(av, l0, acc0, 0, 0, 0);
            acc1 = __builtin_amdgcn_mfma_f32_16x16x32_bf16(av, h1, acc1, 0, 0, 0); acc1 = __builtin_amdgcn_mfma_f32_16x16x32_bf16(av, l1, acc1, 0, 0, 0);
        }
        ss += __shfl_xor(ss, 16); ss += __shfl_xor(ss, 32);
#pragma unroll
        for (int r = 0; r < 4; ++r) { LAS float* tp = T + (kh * 64 + tg * 16 + 4 * fq + r) * 36; tp[fr] = acc0[r]; tp[16 + fr] = acc1[r]; }
        if (fq == 0) T[(kh * 64 + tg * 16 + fr) * 36 + 32] = ss;
        if (F.tid < 16) lcnt[F.tid] = 0;
        LDS_WAIT(); __syncthreads();
        const int tok = tb * 64 + lane;
        int e0 = 0, e1 = 0, rk0 = 0, rk1 = 0; float w0 = 0.f, w1 = 0.f;
        if (F.wave == 0) {
            float s[21];
#pragma unroll
            for (int j = 0; j < 20; ++j) s[j] = T[lane * 36 + j] + T[(64 + lane) * 36 + j];
            s[20] = T[lane * 36 + 32] + T[(64 + lane) * 36 + 32];
            const float r = 1.0f / sqrtf(s[20] * (1.f / DM) + EPS);
            float gl[4];
#pragma unroll
            for (int j = 0; j < 4; ++j) gl[j] = s[j] * r + bg[j];
            int g = 0; float gm = gl[0];
#pragma unroll
            for (int j = 1; j < 4; ++j) if (gl[j] > gm) { gm = gl[j]; g = j; }
            float den = 0.f;
#pragma unroll
            for (int j = 0; j < 4; ++j) den += expf(gl[j] - gm);
            const float gw = 1.0f / den;
            float el[4];
#pragma unroll
            for (int i = 0; i < 4; ++i) { float v = s[4 + i]; v = (g == 1) ? s[8 + i] : v; v = (g == 2) ? s[12 + i] : v; v = (g == 3) ? s[16 + i] : v;
                float bb = be[i]; bb = (g == 1) ? be[4 + i] : bb; bb = (g == 2) ? be[8 + i] : bb; bb = (g == 3) ? be[12 + i] : bb; el[i] = v * r + bb; }
            int i0 = 0; float v0 = el[0];
#pragma unroll
            for (int i = 1; i < 4; ++i) if (el[i] > v0) { v0 = el[i]; i0 = i; }
            int i1 = -1; float v1 = 0.f;
#pragma unroll
            for (int i = 0; i < 4; ++i) if (i != i0 && (i1 < 0 || el[i] > v1)) { v1 = el[i]; i1 = i; }
            const float p0 = 1.0f / (1.0f + expf(v1 - v0));
            w0 = gw * p0; w1 = gw * (1.0f - p0); e0 = 4 * g + i0; e1 = 4 * g + i1;
            rk0 = __hip_atomic_fetch_add(lcnt + e0, 1, __ATOMIC_RELAXED, __HIP_MEMORY_SCOPE_WORKGROUP);
            rk1 = __hip_atomic_fetch_add(lcnt + e1, 1, __ATOMIC_RELAXED, __HIP_MEMORY_SCOPE_WORKGROUP);
            R2[tok] = r;
        }
        LDS_WAIT(); __syncthreads();
        if (F.tid < 16) { const int n = lcnt[F.tid]; int base = 0; if (n > 0) base = (int)__hip_atomic_fetch_add((unsigned*)(F.ctl + CW_CNT + 64 * F.tid), (unsigned)n, RLX_AGENT); lcnt[16 + F.tid] = base; }
        LDS_WAIT(); __syncthreads();
        if (F.wave == 0) {
            rk0 += lcnt[16 + e0]; rk1 += lcnt[16 + e1];
            LIST[e0 * LISTCAP + (rk0 & (LISTCAP - 1))] = tok; LIST[e1 * LISTCAP + (rk1 & (LISTCAP - 1))] = tok;
            *(int4*)(TOKI + 4 * tok) = make_int4(e0, rk0, e1, rk1);
            *(float2*)(TOKW + 2 * tok) = make_float2(w0, w1);
        }
        LDS_WAIT(); __syncthreads();
    }
}

__device__ __forceinline__ void p6_final(Frame& F, const Args& a) {
    const bf16* X1B = (const bf16*)(a.ws + WS_X1B); const bf16* Y = (const bf16*)(a.ws + WS_Y);
    const int* TOKI = (const int*)(a.ws + WS_TOKI); const float* TOKW = (const float*)(a.ws + WS_TOKW); const float* gf = a.in[18];
    int base[16]; { int acc = 0;
#pragma unroll
        for (int e = 0; e < 16; ++e) { int c = (int)__builtin_amdgcn_readfirstlane(__hip_atomic_load(F.ctl + CW_CNT + 64 * e, RLX_AGENT)); if (c > 16384) c = 16384; base[e] = acc * 256; acc += (c + 255) >> 8; } }
    const int gw = F.vcu * NWAVES + F.wave, NGW = F.G * NWAVES, lane = F.lane;
    f32x4 g4[4];
#pragma unroll
    for (int j = 0; j < 2; ++j) { g4[2 * j] = *(const f32x4*)(gf + 512 * j + 8 * lane); g4[2 * j + 1] = *(const f32x4*)(gf + 512 * j + 8 * lane + 4); }
    for (int m = gw; m < M; m += NGW) {
        const int4 ti = *(const int4*)(TOKI + 4 * m); const float2 tw = *(const float2*)(TOKW + 2 * m);
        const int e0 = __builtin_amdgcn_readfirstlane(ti.x), r0 = __builtin_amdgcn_readfirstlane(ti.y), e1 = __builtin_amdgcn_readfirstlane(ti.z), r1 = __builtin_amdgcn_readfirstlane(ti.w);
        int b0 = 0, b1 = 0;
#pragma unroll
        for (int e = 0; e < 16; ++e) { b0 = (e0 == e) ? base[e] : b0; b1 = (e1 == e) ? base[e] : b1; }
        const bf16* xp = X1B + (size_t)m * DM + 8 * lane; const bf16* y0 = Y + (size_t)(b0 + r0) * DM + 8 * lane; const bf16* y1 = Y + (size_t)(b1 + r1) * DM + 8 * lane;
        float v[16]; float s2 = 0.f;
#pragma unroll
        for (int j = 0; j < 2; ++j) {
            const v4u xv = *(const v4u*)(xp + 512 * j), ya = *(const v4u*)(y0 + 512 * j), yb = *(const v4u*)(y1 + 512 * j);
#pragma unroll
            for (int q = 0; q < 4; ++q) { v[8 * j + 2 * q] = bflo(xv[q]) + tw.x * bflo(ya[q]) + tw.y * bflo(yb[q]); v[8 * j + 2 * q + 1] = bfhi(xv[q]) + tw.x * bfhi(ya[q]) + tw.y * bfhi(yb[q]); }
        }
#pragma unroll
        for (int i = 0; i < 16; ++i) s2 += v[i] * v[i];
        const float rstd = 1.0f / sqrtf(wave_sum(s2) * (1.f / DM) + EPS);
        float* op = a.out + (size_t)m * DM + 8 * lane;
#pragma unroll
        for (int j = 0; j < 2; ++j) {
            f32x4 oa, ob;
#pragma unroll
            for (int q = 0; q < 4; ++q) { oa[q] = v[8 * j + q] * rstd * g4[2 * j][q]; ob[q] = v[8 * j + 4 + q] * rstd * g4[2 * j + 1][q]; }
            *(f32x4*)(op + 512 * j) = oa; *(f32x4*)(op + 512 * j + 4) = ob;
        }
    }
}

__global__ void __launch_bounds__(NWAVES * 64, 2) mk_fwd(Args args) {
    extern __shared__ __attribute__((aligned(16))) unsigned char lds[];
    Frame F;
    F.lds = (LAS unsigned char*)lds;
    F.MISC = (volatile LAS unsigned*)(F.lds + MISC_OFF);
    F.tid = threadIdx.x; F.lane = F.tid & 63; F.wave = __builtin_amdgcn_readfirstlane(F.tid >> 6);
    F.G = gridDim.x; { const int bx = blockIdx.x; F.vcu = (F.G % 8 == 0) ? (bx % 8) * (F.G / 8) + bx / 8 : bx; }
    unsigned char* ws = args.ws;
    F.ctl = (gu32*)(ws + WS_CTL);
    for (int u = F.tid; u < (LDS_BYTES - LDSCTL_OFF) / 4; u += NWAVES * 64) ((LAS unsigned*)(F.lds + LDSCTL_OFF))[u] = 0u;
    __syncthreads();
    XcdBarrier bar = xcd_barrier_post((unsigned*)(F.ctl + CW_BAR), F.MISC + 8);
#define GRID_BAR() do { xcd_barrier(bar); if (REPS(9) == 2) xcd_barrier(bar); } while (0)

    if (REPS(0) == 2) { p0_prologue(F, args); __syncthreads(); }
    p0_prologue(F, args);
    GRID_BAR();

    if (PHM & 2) p1_scan(F, args);
    for (int rep = 0; rep < REPS(1); ++rep) {
        pg8::Gemm g{(const pg8::bf16_t*)(ws + WS_XN), (const pg8::bf16_t*)(ws + WS_WIN), DM};
        pg8::StaticOrder S; S.init(M, NPROJ, F.G, (int)blockIdx.x);
        epi::EpiProj E{(pg8::bf16_t*)(ws + WS_QKV), QKV_STRIDE / 2, (const float*)(ws + WS_ROPE), attn_body::C2};
        pg8::gemm_phase<epi::EpiProj, pg8::StaticOrder, true>(F.lds + RING_OFF, g, S, E);
    }
    GRID_BAR();

    for (int rep = 0; rep < REPS(2); ++rep) {
        using abf = attn_body::bf16;
        const abf* QD = (const abf*)(ws + WS_QKV); const abf* KD = QD + QKV_STRIDE / 2; const abf* VD = KD + QKV_STRIDE / 2;
        const abf* QF = VD + QKV_STRIDE / 2; const abf* KF = QF + QKV_STRIDE / 2; const abf* VF = KF + QKV_STRIDE / 2;
        abf* OA = (abf*)(ws + WS_OA); abf* DDp = (abf*)(ws + WS_DD); float* SS = (float*)(ws + WS_SS); const float* GLp = (const float*)(ws + WS_GL);
        float lam;
        { const float a1 = wave_sum(args.in[4][F.lane] * args.in[5][F.lane]), a2 = wave_sum(args.in[6][F.lane] * args.in[7][F.lane]); lam = expf(a1) - expf(a2) + LAM_INIT; }
        char* shm = (char*)lds + RING_OFF;
        for (int it = F.vcu; it < 512; it += F.G) {
            if ((AMM & 1) && it >= 256) {
                const int dp = it - 256, bh = dp >> 4, hf = (dp >> 3) & 1, s = dp & 7, b = bh >> 2, h = bh & 3;
                const long rowbase = (long)b * SEQ;
                for (int k = 0; k < 2; ++k) { const int qb = k ? s : 15 - s;
                    attn_body::attn_unit<1, 8>(rowbase, qb, QD + h * 128, KD + h * 128, VD + h * 128 + hf * 64, DDp, 512, nullptr, 0.f, nullptr, shm);
                    attn_body::attn_unit<2, 8>(rowbase, qb, QD + h * 128 + 64, KD + h * 128 + 64, VD + h * 128 + hf * 64, DDp + h * 128 + hf * 64, 512, nullptr, lam, SS + h * 2 + hf, shm); }
            } else if (AMM & 2) {
                const int bh = it >> 3, s = it & 7, b = bh >> 3, h = bh & 7;
                const long rowbase = (long)b * SEQ;
                for (int k = 0; k < 2; ++k) { const int qb = k ? s : 15 - s;
                    attn_body::attn_unit<0, 8>(rowbase, qb, QF + h * 64, KF + h * 64, VF + h * 64, OA + 512 + h * 64, 1024, GLp + bh * 4096, 0.f, nullptr, shm); }
            }
        }
    }
    GRID_BAR();

    for (int rep = 0; rep < REPS(3); ++rep) p25_diffnorm(F, args);
    GRID_BAR();

    for (int rep = 0; rep < REPS(4); ++rep) {
        pg8::Gemm g{(const pg8::bf16_t*)(ws + WS_OA), (const pg8::bf16_t*)(ws + WS_WOUT), DM};
        pg8::StaticOrder S; S.init(M, DM, F.G, (int)blockIdx.x);
        epi::EpiRes E{args.in[0], (pg8::bf16_t*)(ws + WS_X1B)};
        pg8::gemm_phase<epi::EpiRes, pg8::StaticOrder, true>(F.lds + RING_OFF, g, S, E);
    }
    GRID_BAR();

    p35_route(F, args);
    GRID_BAR();

    for (int rep = 0; rep < REPS(6); ++rep) {
        pg8::Gemm g{(const pg8::bf16_t*)(ws + WS_X1B), (const pg8::bf16_t*)(ws + WS_WGU), DM};
        pg8::ExpertOrder<true> S; S.init((const unsigned*)(F.ctl + CW_CNT), F.G, (int)blockIdx.x, (const int*)(ws + WS_LIST));
        epi::EpiSwiglu E{(pg8::bf16_t*)(ws + WS_ACT), (const int*)(ws + WS_LIST), (const float*)(ws + WS_R2)};
        pg8::gemm_phase<epi::EpiSwiglu, pg8::ExpertOrder<true>, true>(F.lds + RING_OFF, g, S, E);
    }
    GRID_BAR();

    for (int rep = 0; rep < REPS(7); ++rep) {
        pg8::Gemm g{(const pg8::bf16_t*)(ws + WS_ACT), (const pg8::bf16_t*)(ws + WS_WD), DEXP};
        pg8::ExpertOrder<false> S; S.init((const unsigned*)(F.ctl + CW_CNT), F.G, (int)blockIdx.x, nullptr);
        epi::EpiY E{(pg8::bf16_t*)(ws + WS_Y)};
        pg8::gemm_phase<epi::EpiY, pg8::ExpertOrder<false>, true>(F.lds + RING_OFF, g, S, E);
    }
    GRID_BAR();

    for (int rep = 0; rep < REPS(8); ++rep) p6_final(F, args);
}

extern "C" void kernel_launch(void* const* d_in, const int* in_sizes, int n_in, void* d_out, int out_size, void* d_ws, size_t ws_size, hipStream_t stream) {
    static int grid = 0;
    if (grid == 0) {
        if (n_in != 19 || in_sizes[0] != M * DM || out_size != M * DM || ws_size < WS_END) { fprintf(stderr, "kernel_launch: unexpected shapes (n_in %d, in0 %d, out %d, ws %zu); nothing launched\n", n_in, n_in > 0 ? in_sizes[0] : -1, out_size, ws_size); grid = -1; return; }
        int dev = 0, cus = 0, per_cu = 0;
        if (hipGetDevice(&dev) != hipSuccess || hipDeviceGetAttribute(&cus, hipDeviceAttributeMultiprocessorCount, dev) != hipSuccess) { grid = -1; return; }
        if (hipFuncSetAttribute((const void*)mk_fwd, hipFuncAttributeMaxDynamicSharedMemorySize, LDS_BYTES) != hipSuccess) { fprintf(stderr, "kernel_launch: hipFuncSetAttribute failed\n"); grid = -1; return; }
        if (hipOccupancyMaxActiveBlocksPerMultiprocessor(&per_cu, (const void*)mk_fwd, NWAVES * 64, LDS_BYTES) != hipSuccess || per_cu < 1) { fprintf(stderr, "kernel_launch: occupancy query says %d blocks per CU\n", per_cu); (void)hipGetLastError(); grid = -1; return; }
        grid = cus;
    }
    if (grid < 0) return;
    if (hipMemsetAsync((char*)d_ws + WS_CTL, 0, CTL_ZERO_BYTES, stream) != hipSuccess) { fprintf(stderr, "kernel_launch: hipMemsetAsync failed\n"); return; }
    Args a{};
    for (int i = 0; i < 19; ++i) a.in[i] = (const float*)d_in[i];
    a.out = (float*)d_out; a.ws = (unsigned char*)d_ws;
#ifndef MK_COOP
#define MK_COOP 1
#endif
#if MK_COOP
    void* kargs[] = {&a};
    hipError_t e = hipLaunchCooperativeKernel((const void*)mk_fwd, dim3(grid), dim3(NWAVES * 64), kargs, LDS_BYTES, stream);
    if (e != hipSuccess) fprintf(stderr, "kernel_launch: cooperative launch failed: %s (grid %d)\n", hipGetErrorString(e), grid);
#else
    hipLaunchKernelGGL(mk_fwd, dim3(grid), dim3(NWAVES * 64), LDS_BYTES, stream, a);
    const hipError_t e = hipPeekAtLastError();
    if (e != hipSuccess) fprintf(stderr, "kernel_launch: launch failed: %s (grid %d)\n", hipGetErrorName(e), grid);
#endif
}
```
